# Optimizing an MI355X kernel written in HIP

```python
import jax, jax.numpy as jnp
from jax import lax
import numpy as np

D_MODEL = 1024
BATCH = 4
SEQ = 8192
DEPTH = 1

RET_HEADS = 8
RET_HEAD_DIM = 64
RET_WIDTH = RET_HEADS * RET_HEAD_DIM
RET_CHUNK = 128
MLA_HEADS = 8
MLA_NOPE_DIM = 64
MLA_ROPE_DIM = 32
MLA_V_DIM = 64
MLA_Q_RANK = 256
MLA_KV_RANK = 128
MLA_WIDTH = MLA_HEADS * MLA_V_DIM
MIX_WIDTH = RET_WIDTH + MLA_WIDTH
IN_WIDTH = 4 * RET_WIDTH + MLA_Q_RANK + MLA_KV_RANK + MLA_ROPE_DIM
D_FF = 2816
CONV_WIDTH = 3
Q_BLOCK = 128
ROPE_BASE = 10000.0
EPS = 1e-6

kernel_name = "hybrid_retention_mla_convffn"


def rms_norm(x, w):
    xf = x.astype(jnp.float32)
    y = xf * lax.rsqrt(jnp.mean(xf * xf, axis=-1, keepdims=True) + EPS)
    return (y * w.astype(jnp.float32)).astype(x.dtype)


def rope(x, positions):
    d = x.shape[-1]
    inv_freq = ROPE_BASE ** (-jnp.arange(0, d, 2, dtype=jnp.float32) / d)
    ang = positions.astype(jnp.float32)[..., None] * inv_freq
    if x.ndim == 4:
        ang = ang[:, :, None, :]
    cos, sin = jnp.cos(ang), jnp.sin(ang)
    xf = x.astype(jnp.float32)
    x1, x2 = xf[..., : d // 2], xf[..., d // 2:]
    return jnp.concatenate([x1 * cos - x2 * sin, x1 * sin + x2 * cos], axis=-1).astype(x.dtype)


def retention(q, k, v):
    B, S, H, dk = q.shape
    dv = v.shape[-1]
    C = RET_CHUNK
    N = S // C
    log_gamma = jnp.log1p(-jnp.power(2.0, -5.0 - jnp.arange(H, dtype=jnp.float32)))
    qc = q.astype(jnp.float32).reshape(B, N, C, H, dk)
    kc = k.astype(jnp.float32).reshape(B, N, C, H, dk)
    vc = v.astype(jnp.float32).reshape(B, N, C, H, dv)
    idx = jnp.arange(C, dtype=jnp.float32)
    diff = idx[:, None] - idx[None, :]
    decay_mask = jnp.where(diff >= 0, jnp.exp(log_gamma[:, None, None] * jnp.maximum(diff, 0.0)), 0.0)
    scores = jnp.einsum('bnihd,bnjhd->bnhij', qc, kc) * decay_mask
    o_inner = jnp.einsum('bnhij,bnjhe->bnihe', scores, vc)
    zeta = jnp.exp(log_gamma[:, None] * (C - 1.0 - idx))
    chunk_states = jnp.einsum('bnjhd,hj,bnjhe->nbhde', kc, zeta, vc)
    chunk_decay = jnp.exp(log_gamma * C)[None, :, None, None]

    def step(R, s_n):
        return chunk_decay * R + s_n, R

    _, r_prev = lax.scan(step, jnp.zeros((B, H, dk, dv), jnp.float32), chunk_states)
    r_prev = jnp.moveaxis(r_prev, 0, 1)
    xi = jnp.exp(log_gamma[:, None] * (idx + 1.0))
    o_cross = jnp.einsum('bnihd,bnhde,hi->bnihe', qc, r_prev, xi)
    return (o_inner + o_cross).reshape(B, S, H, dv)


def retention_group(q, k, v, g, positions, gn_w):
    B, S, _ = q.shape
    q = rope(q.reshape(B, S, RET_HEADS, RET_HEAD_DIM), positions)
    k = rope(k.reshape(B, S, RET_HEADS, RET_HEAD_DIM), positions) * (RET_HEAD_DIM ** -0.5)
    v = v.reshape(B, S, RET_HEADS, RET_HEAD_DIM)
    o = retention(q, k, v)
    mu = jnp.mean(o, axis=-1, keepdims=True)
    var = jnp.mean(jnp.square(o - mu), axis=-1, keepdims=True)
    o = ((o - mu) * lax.rsqrt(var + EPS)).reshape(B, S, RET_WIDTH) * gn_w.astype(jnp.float32)
    return (jax.nn.silu(g.astype(jnp.float32)) * o).astype(g.dtype)


def mla_group(c_q, c_kv, k_pe, positions, q_norm_w, w_uq, kv_norm_w, w_ukv):
    B, S, _ = c_q.shape
    H = MLA_HEADS
    q = jnp.einsum('bsr,rf->bsf', rms_norm(c_q, q_norm_w), w_uq).reshape(B, S, H, MLA_NOPE_DIM + MLA_ROPE_DIM)
    q_nope = q[..., :MLA_NOPE_DIM]
    q_pe = rope(q[..., MLA_NOPE_DIM:], positions)
    kv = jnp.einsum('bsr,rf->bsf', rms_norm(c_kv, kv_norm_w), w_ukv).reshape(B, S, H, MLA_NOPE_DIM + MLA_V_DIM)
    k_nope = kv[..., :MLA_NOPE_DIM]
    v = kv[..., MLA_NOPE_DIM:]
    k_pe = rope(k_pe, positions)
    scale = (MLA_NOPE_DIM + MLA_ROPE_DIM) ** -0.5
    N = S // Q_BLOCK
    qn_b = jnp.moveaxis(q_nope.reshape(B, N, Q_BLOCK, H, MLA_NOPE_DIM), 1, 0)
    qp_b = jnp.moveaxis(q_pe.reshape(B, N, Q_BLOCK, H, MLA_ROPE_DIM), 1, 0)
    key_pos = jnp.arange(S)
    neg = jnp.finfo(jnp.float32).min

    def block(args):
        qn, qp, blk = args
        s = (jnp.einsum('bqhd,bkhd->bhqk', qn, k_nope)
             + jnp.einsum('bqhr,bkr->bhqk', qp, k_pe)).astype(jnp.float32) * scale
        q_pos = blk * Q_BLOCK + jnp.arange(Q_BLOCK)
        s = jnp.where(key_pos[None, :] <= q_pos[:, None], s, neg)
        p = jax.nn.softmax(s, axis=-1).astype(v.dtype)
        return jnp.einsum('bhqk,bkhd->bqhd', p, v)

    o = lax.map(block, (qn_b, qp_b, jnp.arange(N)))
    return jnp.moveaxis(o, 0, 1).reshape(B, S, MLA_WIDTH)


def conv_ffn(h, w_up, conv_w, conv_b, w_down):
    S = h.shape[1]
    u = jnp.einsum('bsd,df->bsf', h, w_up)
    up = jnp.pad(u, ((0, 0), (CONV_WIDTH - 1, 0), (0, 0)))
    u = conv_b + sum(conv_w[j] * up[:, j:j + S] for j in range(CONV_WIDTH))
    gate, val = u[..., :D_FF], u[..., D_FF:]
    return jnp.einsum('bsf,fd->bsd', jax.nn.silu(gate) * val, w_down)


def setup_inputs(seed: int = 0) -> dict:
    key = jax.random.key(seed)
    ks = jax.random.split(key, 20)
    f32 = jnp.float32

    def nrm(k, shape, fan_in):
        return jax.random.normal(k, shape, f32) * (fan_in ** -0.5)

    def gain(k, shape):
        return 1.0 + 0.02 * jax.random.normal(k, shape, f32)

    x = jax.random.normal(ks[0], (BATCH, SEQ, D_MODEL), f32)
    offset = jax.random.randint(ks[1], (BATCH, 1), 0, 4096, dtype=jnp.int32)
    positions = (offset + jnp.arange(SEQ, dtype=jnp.int32)[None, :]).astype(jnp.int32)
    return {
        "x": x,
        "positions": positions,
        "attn_norm_w": gain(ks[2], (DEPTH, D_MODEL)),
        "w_in": nrm(ks[3], (DEPTH, D_MODEL, IN_WIDTH), D_MODEL),
        "ret_gn_w": gain(ks[4], (DEPTH, RET_WIDTH)),
        "mla_q_norm_w": gain(ks[5], (DEPTH, MLA_Q_RANK)),
        "w_uq": nrm(ks[6], (DEPTH, MLA_Q_RANK, MLA_HEADS * (MLA_NOPE_DIM + MLA_ROPE_DIM)), MLA_Q_RANK),
        "mla_kv_norm_w": gain(ks[7], (DEPTH, MLA_KV_RANK)),
        "w_ukv": nrm(ks[8], (DEPTH, MLA_KV_RANK, MLA_HEADS * (MLA_NOPE_DIM + MLA_V_DIM)), MLA_KV_RANK),
        "w_out": nrm(ks[9], (DEPTH, MIX_WIDTH, D_MODEL), MIX_WIDTH),
        "ffn_norm_w": gain(ks[10], (DEPTH, D_MODEL)),
        "w_up": nrm(ks[11], (DEPTH, D_MODEL, 2 * D_FF), D_MODEL),
        "conv_w": nrm(ks[12], (DEPTH, CONV_WIDTH, 2 * D_FF), CONV_WIDTH),
        "conv_b": 0.01 * jax.random.normal(ks[13], (DEPTH, 2 * D_FF), f32),
        "w_down": nrm(ks[14], (DEPTH, D_FF, D_MODEL), D_FF),
        "final_norm_w": gain(ks[15], (D_MODEL,)),
    }


def reference(x, positions, attn_norm_w, w_in, ret_gn_w, mla_q_norm_w, w_uq, mla_kv_norm_w, w_ukv,
              w_out, ffn_norm_w, w_up, conv_w, conv_b, w_down, final_norm_w):
    splits = np.cumsum([RET_WIDTH, RET_WIDTH, RET_WIDTH, RET_WIDTH, MLA_Q_RANK, MLA_KV_RANK]).tolist()
    for l in range(DEPTH):
        h = rms_norm(x, attn_norm_w[l])
        proj = jnp.einsum('bsd,df->bsf', h, w_in[l])
        r_q, r_k, r_v, r_g, c_q, c_kv, k_pe = jnp.split(proj, splits, axis=-1)
        y_ret = retention_group(r_q, r_k, r_v, r_g, positions, ret_gn_w[l])
        y_mla = mla_group(c_q, c_kv, k_pe, positions, mla_q_norm_w[l], w_uq[l],
                          mla_kv_norm_w[l], w_ukv[l])
        mixed = jnp.concatenate([y_ret, y_mla.astype(y_ret.dtype)], axis=-1)
        x = x + jnp.einsum('bsm,md->bsd', mixed, w_out[l])
        x = x + conv_ffn(rms_norm(x, ffn_norm_w[l]), w_up[l], conv_w[l], conv_b[l], w_down[l])
    return rms_norm(x, final_norm_w)
```

```cpp
#include <hip/hip_runtime.h>
#include <cstdint>
#include <cstdio>

constexpr int NB = 4, SEQ = 8192, NT = NB * SEQ, DM = 1024;
constexpr int INW = 2464, FF = 2816, FF2 = 5632;
constexpr int SEQP = 8448;
constexpr float EPS = 1e-6f;
constexpr float QSCALE = 0.10206207261596577f * 1.4426950408889634f;

typedef unsigned short bf16_t;
__device__ __forceinline__ float bf2f(bf16_t v) { return __uint_as_float(((unsigned)v) << 16); }
__device__ __forceinline__ bf16_t f2bf(float f) { unsigned u = __float_as_uint(f); return (bf16_t)((u + 0x7fffu + ((u >> 16) & 1u)) >> 16); }
__device__ __forceinline__ float wave_sum(float v) {
#pragma unroll
    for (int o = 1; o < 64; o <<= 1) v += __shfl_xor(v, o);
    return v;
}
__device__ __forceinline__ float wave_max(float v) {
#pragma unroll
    for (int o = 1; o < 64; o <<= 1) v = fmaxf(v, __shfl_xor(v, o));
    return v;
}

constexpr size_t MiB = 1u << 20;
constexpr size_t WS_CTL = 0;
constexpr size_t WS_RS1 = 1 * MiB;
constexpr size_t WS_SSQ = 1 * MiB + 512 * 1024;
constexpr size_t WS_SSKV = 2 * MiB;
constexpr size_t WS_SS2 = 3 * MiB;
constexpr size_t WS_SS3 = 5 * MiB;
constexpr size_t WS_RTRET = 8 * MiB;
constexpr size_t WS_RTMLA = 16 * MiB;
constexpr size_t WS_WIN = 20 * MiB, WS_WUQ = 25 * MiB, WS_WUKV = 25 * MiB + 512 * 1024, WS_WOUT = 26 * MiB, WS_WUP = 28 * MiB, WS_WDOWN = 39 * MiB;
constexpr size_t WS_XB = 48 * MiB;
constexpr size_t WS_X1B = 48 * MiB;
constexpr size_t WS_RQ = 114 * MiB, WS_RK = 146 * MiB, WS_RV = 178 * MiB, WS_RG = 210 * MiB;
constexpr size_t WS_CQ = 242 * MiB, WS_CKV = 258 * MiB, WS_KPE = 266 * MiB;
constexpr size_t WS_QB = 268 * MiB, WS_KVB = 316 * MiB;
constexpr size_t WS_NS = 380 * MiB;
constexpr size_t WS_MIX = 412 * MiB;
constexpr size_t WS_ACT = 114 * MiB;
constexpr size_t WS_END = 476 * MiB;

__global__ void __launch_bounds__(256) k_tables(const int* __restrict__ pos, float2* __restrict__ rt_ret, float2* __restrict__ rt_mla) {
    const int idx = blockIdx.x * 256 + threadIdx.x;
    if (idx >= NT * 48) return;
    const int t = idx / 48, j = idx % 48;
    const bool mla = j >= 32; const int i = mla ? j - 32 : j;
    const double ex = mla ? -(double)i / 16.0 : -(double)i / 32.0;
    const float inv = (float)exp2(ex * 13.287712379549449);
    const float ang = (float)pos[t] * inv;
    const double a = (double)ang;
    const double n = rint(a * 0.6366197723675814);
    const double r = a - n * 1.5707963267948966;
    const double r2 = r * r;
    const double sn = r + r * r2 * (-1.0 / 6 + r2 * (1.0 / 120 + r2 * (-1.0 / 5040 + r2 * (1.0 / 362880 - r2 / 39916800.0))));
    const double cs = 1.0 + r2 * (-0.5 + r2 * (1.0 / 24 + r2 * (-1.0 / 720 + r2 * (1.0 / 40320 + r2 * (-1.0 / 3628800 + r2 / 479001600.0)))));
    const int q = ((int)n) & 3;
    float c, s;
    if (q == 0) { c = (float)cs; s = (float)sn; } else if (q == 1) { c = (float)-sn; s = (float)cs; } else if (q == 2) { c = (float)-cs; s = (float)-sn; } else { c = (float)sn; s = (float)-cs; }
    if (mla) rt_mla[t * 16 + i] = make_float2(c, s); else rt_ret[t * 32 + i] = make_float2(c, s);
}

__global__ void __launch_bounds__(256) nk1_inproj(const float* __restrict__ x, const float* __restrict__ nw, const float* __restrict__ w_in,
        const float2* __restrict__ rt_ret, const float2* __restrict__ rt_mla,
        bf16_t* RQ, bf16_t* RK, bf16_t* RV, bf16_t* RG, bf16_t* CQ, bf16_t* CKV, bf16_t* KPE, float* SSQ, float* SSKV) {
    __shared__ float h[4][1024];
    __shared__ float pr[4][INW];
    const int t0 = blockIdx.x * 4, tid = threadIdx.x, w = tid >> 6, lane = tid & 63;
    {
        const float* xr = x + (size_t)(t0 + w) * DM; float v[16]; float s = 0.f;
#pragma unroll
        for (int j = 0; j < 16; ++j) { v[j] = xr[lane + 64 * j]; s += v[j] * v[j]; }
        s = wave_sum(s); const float rs = rsqrtf(s * (1.0f / DM) + EPS);
#pragma unroll
        for (int j = 0; j < 16; ++j) h[w][lane + 64 * j] = v[j] * rs * nw[lane + 64 * j];
    }
    __syncthreads();
    for (int c = tid; c < INW; c += 256) {
        float a0 = 0.f, a1 = 0.f, a2 = 0.f, a3 = 0.f;
        for (int k = 0; k < DM; ++k) { const float wv = w_in[(size_t)k * INW + c]; a0 += h[0][k] * wv; a1 += h[1][k] * wv; a2 += h[2][k] * wv; a3 += h[3][k] * wv; }
        pr[0][c] = a0; pr[1][c] = a1; pr[2][c] = a2; pr[3][c] = a3;
    }
    __syncthreads();
    for (int idx = tid; idx < 4 * INW; idx += 256) {
        const int r = idx / INW, c = idx % INW; const int t = t0 + r; const float v = pr[r][c];
        if (c < 1024) {
            const int cc = c & 511, i = cc & 63, f = i & 31; const float2 cs = rt_ret[(size_t)t * 32 + f];
            const float x1 = pr[r][c - i + f], x2 = pr[r][c - i + f + 32];
            const float o = (i < 32) ? x1 * cs.x - x2 * cs.y : x1 * cs.y + x2 * cs.x;
            if (c < 512) RQ[(size_t)t * 512 + cc] = f2bf(o); else RK[(size_t)t * 512 + cc] = f2bf(o * 0.125f);
        } else if (c < 1536) RV[(size_t)t * 512 + c - 1024] = f2bf(v);
        else if (c < 2048) RG[(size_t)t * 512 + c - 1536] = f2bf(v);
        else if (c < 2304) CQ[(size_t)t * 256 + c - 2048] = f2bf(v);
        else if (c < 2432) CKV[(size_t)t * 128 + c - 2304] = f2bf(v);
        else { const int i = c - 2432, f = i & 15; const float2 cs = rt_mla[(size_t)t * 16 + f];
            const float x1 = pr[r][2432 + f], x2 = pr[r][2432 + f + 16];
            const float o = (i < 16) ? x1 * cs.x - x2 * cs.y : x1 * cs.y + x2 * cs.x;
            KPE[(size_t)t * 32 + i] = f2bf(o); }
    }
    {
        const int t = t0 + w; float s = 0.f;
#pragma unroll
        for (int j = 0; j < 4; ++j) { const float v = pr[w][2048 + lane + 64 * j]; s += v * v; }
        s = wave_sum(s);
        float s2 = 0.f;
#pragma unroll
        for (int j = 0; j < 2; ++j) { const float v = pr[w][2304 + lane + 64 * j]; s2 += v * v; }
        s2 = wave_sum(s2);
        if (lane == 0) { SSQ[t * 4] = s; SSQ[t * 4 + 1] = 0.f; SSQ[t * 4 + 2] = 0.f; SSQ[t * 4 + 3] = 0.f; SSKV[t * 2] = s2; SSKV[t * 2 + 1] = 0.f; }
    }
}

__global__ void __launch_bounds__(256) nk2_mlaup(const bf16_t* __restrict__ CQ, const bf16_t* __restrict__ CKV, const float* __restrict__ SSQ, const float* __restrict__ SSKV,
        const float* __restrict__ qnw, const float* __restrict__ w_uq, const float* __restrict__ kvnw, const float* __restrict__ w_ukv,
        const float2* __restrict__ rt_mla, bf16_t* QB, bf16_t* KVB) {
    __shared__ float cq[4][256];
    __shared__ float ckv[4][128];
    __shared__ float q[4][768];
    const int t0 = blockIdx.x * 4, tid = threadIdx.x, w = tid >> 6, lane = tid & 63;
    {
        const int t = t0 + w;
        const float rsq = rsqrtf((SSQ[t * 4] + SSQ[t * 4 + 1] + SSQ[t * 4 + 2] + SSQ[t * 4 + 3]) * (1.0f / 256) + EPS);
        const float rskv = rsqrtf((SSKV[t * 2] + SSKV[t * 2 + 1]) * (1.0f / 128) + EPS);
#pragma unroll
        for (int j = 0; j < 4; ++j) cq[w][lane + 64 * j] = bf2f(CQ[(size_t)t * 256 + lane + 64 * j]) * rsq * qnw[lane + 64 * j];
#pragma unroll
        for (int j = 0; j < 2; ++j) ckv[w][lane + 64 * j] = bf2f(CKV[(size_t)t * 128 + lane + 64 * j]) * rskv * kvnw[lane + 64 * j];
    }
    __syncthreads();
    for (int c = tid; c < 768; c += 256) {
        float a0 = 0.f, a1 = 0.f, a2 = 0.f, a3 = 0.f;
        for (int k = 0; k < 256; ++k) { const float wv = w_uq[(size_t)k * 768 + c]; a0 += cq[0][k] * wv; a1 += cq[1][k] * wv; a2 += cq[2][k] * wv; a3 += cq[3][k] * wv; }
        q[0][c] = a0; q[1][c] = a1; q[2][c] = a2; q[3][c] = a3;
    }
    for (int c = tid; c < 1024; c += 256) {
        float a0 = 0.f, a1 = 0.f, a2 = 0.f, a3 = 0.f;
        for (int k = 0; k < 128; ++k) { const float wv = w_ukv[(size_t)k * 1024 + c]; a0 += ckv[0][k] * wv; a1 += ckv[1][k] * wv; a2 += ckv[2][k] * wv; a3 += ckv[3][k] * wv; }
        KVB[(size_t)(t0 + 0) * 1024 + c] = f2bf(a0); KVB[(size_t)(t0 + 1) * 1024 + c] = f2bf(a1); KVB[(size_t)(t0 + 2) * 1024 + c] = f2bf(a2); KVB[(size_t)(t0 + 3) * 1024 + c] = f2bf(a3);
    }
    __syncthreads();
    for (int idx = tid; idx < 4 * 768; idx += 256) {
        const int r = idx / 768, c = idx % 768, t = t0 + r; const int hd = c / 96, d = c % 96; float o;
        if (d < 64) o = q[r][c];
        else { const int i = d - 64, f = i & 15; const float2 cs = rt_mla[(size_t)t * 16 + f];
            const float x1 = q[r][hd * 96 + 64 + f], x2 = q[r][hd * 96 + 64 + f + 16];
            o = (i < 16) ? x1 * cs.x - x2 * cs.y : x1 * cs.y + x2 * cs.x; }
        QB[(size_t)t * 768 + c] = f2bf(o * QSCALE);
    }
}

__device__ __forceinline__ float ret_lg(int h) { return log1pf(-exp2f(-5.0f - (float)h)); }
__global__ void __launch_bounds__(256) nk3_states(const bf16_t* __restrict__ RK, const bf16_t* __restrict__ RV, float* __restrict__ NS) {
    __shared__ bf16_t ks[128][64];
    __shared__ bf16_t vs[128][64];
    const int u = blockIdx.x, n = u & 63, bh = u >> 6, h = bh & 7, b = bh >> 3, tid = threadIdx.x;
    const size_t tb = (size_t)b * SEQ + (size_t)n * 128;
    for (int i = tid; i < 128 * 64; i += 256) { const int j = i >> 6, d = i & 63; ks[j][d] = RK[(tb + j) * 512 + h * 64 + d]; vs[j][d] = RV[(tb + j) * 512 + h * 64 + d]; }
    __syncthreads();
    const float lg = ret_lg(h);
    float acc[16];
#pragma unroll
    for (int i = 0; i < 16; ++i) acc[i] = 0.f;
    for (int j = 0; j < 128; ++j) {
        const float z = expf(lg * (127.0f - (float)j));
#pragma unroll
        for (int i = 0; i < 16; ++i) { const int idx = tid + 256 * i, d = idx >> 6, e = idx & 63; acc[i] += bf2f(ks[j][d]) * z * bf2f(vs[j][e]); }
    }
#pragma unroll
    for (int i = 0; i < 16; ++i) NS[(size_t)u * 4096 + tid + 256 * i] = acc[i];
}
__global__ void __launch_bounds__(256) nk3_scan(float* __restrict__ NS) {
    const int g = blockIdx.x * 256 + threadIdx.x; const int bh = g >> 12, el = g & 4095, h = bh & 7;
    const float cd = expf(ret_lg(h) * 128.0f);
    float R = 0.f;
    for (int n = 0; n < 64; ++n) { float* p = NS + ((size_t)(bh * 64 + n)) * 4096 + el; const float s = *p; *p = R; R = cd * R + s; }
}
constexpr int NK3O_LDS = 3 * 16384 + 16384 + 64 * 129 * 4 + 64 * 65 * 4;
__global__ void __launch_bounds__(256) nk3_out(const bf16_t* __restrict__ RQ, const bf16_t* __restrict__ RK, const bf16_t* __restrict__ RV, const bf16_t* __restrict__ RG,
        const float* __restrict__ NS, const float* __restrict__ gnw, bf16_t* __restrict__ MIX) {
    extern __shared__ __attribute__((aligned(16))) unsigned char smem[];
    bf16_t (*qs)[64] = (bf16_t(*)[64])smem;
    bf16_t (*ks)[64] = (bf16_t(*)[64])(smem + 16384);
    bf16_t (*vs)[64] = (bf16_t(*)[64])(smem + 32768);
    float (*Rp)[64] = (float(*)[64])(smem + 49152);
    float (*sc)[129] = (float(*)[129])(smem + 65536);
    float (*ob)[65] = (float(*)[65])(smem + 65536 + 64 * 129 * 4);
    const int u = blockIdx.x, n = u & 63, bh = u >> 6, h = bh & 7, b = bh >> 3, tid = threadIdx.x, w = tid >> 6, lane = tid & 63;
    const size_t tb = (size_t)b * SEQ + (size_t)n * 128;
    for (int i = tid; i < 128 * 64; i += 256) { const int j = i >> 6, d = i & 63; const size_t o = (tb + j) * 512 + h * 64 + d; qs[j][d] = RQ[o]; ks[j][d] = RK[o]; vs[j][d] = RV[o]; }
    for (int i = tid; i < 4096; i += 256) Rp[i >> 6][i & 63] = NS[(size_t)u * 4096 + i];
    __syncthreads();
    const float lg = ret_lg(h);
    for (int half = 0; half < 2; ++half) {
        const int i0 = half * 64;
        for (int it = 0; it < 32; ++it) {
            const int idx = tid + 256 * it, i = idx >> 7, j = idx & 127, ig = i0 + i; float v = 0.f;
            if (j <= ig) { float a = 0.f;
                for (int d = 0; d < 64; ++d) a += bf2f(qs[ig][d]) * bf2f(ks[j][d]);
                v = a * expf(lg * (float)(ig - j)); }
            sc[i][j] = v;
        }
        __syncthreads();
        for (int it = 0; it < 16; ++it) {
            const int idx = tid + 256 * it, i = idx >> 6, e = idx & 63, ig = i0 + i; float a = 0.f;
            for (int j = 0; j <= ig; ++j) a += sc[i][j] * bf2f(vs[j][e]);
            float c = 0.f;
            for (int d = 0; d < 64; ++d) c += bf2f(qs[ig][d]) * Rp[d][e];
            ob[i][e] = a + c * expf(lg * (float)(ig + 1));
        }
        __syncthreads();
        for (int rr = 0; rr < 16; ++rr) {
            const int i = w * 16 + rr, ig = i0 + i; const size_t t = tb + ig;
            const float v = ob[i][lane]; const float mu = wave_sum(v) * (1.0f / 64); const float dv = v - mu; const float var = wave_sum(dv * dv) * (1.0f / 64);
            const float y = dv * rsqrtf(var + EPS) * gnw[h * 64 + lane];
            const float g = bf2f(RG[t * 512 + h * 64 + lane]);
            MIX[t * 1024 + h * 64 + lane] = f2bf(g / (1.0f + expf(-g)) * y);
        }
        __syncthreads();
    }
}

__global__ void __launch_bounds__(512) nk3_attn(const bf16_t* __restrict__ QB, const bf16_t* __restrict__ KVB, const bf16_t* __restrict__ KPE, bf16_t* __restrict__ MIX) {
    __shared__ __attribute__((aligned(16))) bf16_t kt[64][104];
    __shared__ __attribute__((aligned(16))) bf16_t vt[64][64];
    __shared__ float qv[8][96];
    __shared__ float ps[8][64];
    const int tid = threadIdx.x, w = tid >> 6, lane = tid & 63;
    const int bh = blockIdx.x >> 10, sblk = blockIdx.x & 1023, b = bh >> 3, h = bh & 7;
    const int s = sblk * 8 + w; const size_t t = (size_t)b * SEQ + s;
    for (int d = lane; d < 96; d += 64) qv[w][d] = bf2f(QB[t * 768 + h * 96 + d]);
    float m = -INFINITY, l = 0.f, o = 0.f;
    const int ntile = (sblk * 8 + 7) / 64 + 1;
    for (int kb = 0; kb < ntile; ++kb) {
        __syncthreads();
        {
            const int r = tid >> 3, c = tid & 7; const size_t tk = (size_t)b * SEQ + kb * 64 + r;
            *(uint4*)&kt[r][c * 8] = *(const uint4*)&KVB[tk * 1024 + h * 128 + c * 8];
            *(uint4*)&vt[r][c * 8] = *(const uint4*)&KVB[tk * 1024 + h * 128 + 64 + c * 8];
            if (tid < 256) { const int r2 = tid >> 2, c2 = tid & 3; const size_t tk2 = (size_t)b * SEQ + kb * 64 + r2; *(uint4*)&kt[r2][64 + c2 * 8] = *(const uint4*)&KPE[tk2 * 32 + c2 * 8]; }
        }
        __syncthreads();
        const int key = kb * 64 + lane; const bool valid = key <= s;
        float a = 0.f;
        for (int d = 0; d < 96; ++d) a += qv[w][d] * bf2f(kt[lane][d]);
        const float scv = valid ? a : -INFINITY;
        const float mn = fmaxf(m, wave_max(scv));
        const float p = valid ? exp2f(a - mn) : 0.f;
        const float alpha = exp2f(m - mn);
        l = l * alpha + wave_sum(p);
        ps[w][lane] = p;
        __builtin_amdgcn_s_waitcnt(0);
        float acc = 0.f;
        for (int j = 0; j < 64; ++j) acc += ps[w][j] * bf2f(vt[j][lane]);
        o = o * alpha + acc; m = mn;
    }
    MIX[t * 1024 + 512 + h * 64 + lane] = f2bf(o / l);
}

__device__ __forceinline__ size_t prow(int t) { const int b = t / SEQ, s = t % SEQ; return (size_t)b * SEQP + 2 + s; }
__global__ void __launch_bounds__(256) nk4_outproj(const float* __restrict__ x, const bf16_t* __restrict__ MIX, const float* __restrict__ w_out,
        float* __restrict__ X1, bf16_t* __restrict__ X1B, float* __restrict__ SS2) {
    __shared__ float mx[4][1024];
    __shared__ float red[4][4];
    const int t0 = blockIdx.x * 4, tid = threadIdx.x, w = tid >> 6, lane = tid & 63;
    for (int i = tid; i < 4096; i += 256) mx[i >> 10][i & 1023] = bf2f(MIX[(size_t)t0 * 1024 + i]);
    if ((t0 % SEQ) == 0) { const int b = t0 / SEQ; for (int i = tid; i < 2048; i += 256) X1B[(size_t)b * SEQP * 1024 + i] = 0; }
    __syncthreads();
    float ss[4] = {0.f, 0.f, 0.f, 0.f};
    for (int c = tid; c < 1024; c += 256) {
        float a0 = 0.f, a1 = 0.f, a2 = 0.f, a3 = 0.f;
        for (int k = 0; k < 1024; ++k) { const float wv = w_out[(size_t)k * 1024 + c]; a0 += mx[0][k] * wv; a1 += mx[1][k] * wv; a2 += mx[2][k] * wv; a3 += mx[3][k] * wv; }
        float v[4] = {a0, a1, a2, a3};
#pragma unroll
        for (int r = 0; r < 4; ++r) { const float x1 = x[(size_t)(t0 + r) * 1024 + c] + v[r]; X1[(size_t)(t0 + r) * 1024 + c] = x1; X1B[prow(t0 + r) * 1024 + c] = f2bf(x1); ss[r] += x1 * x1; }
    }
#pragma unroll
    for (int r = 0; r < 4; ++r) { const float s = wave_sum(ss[r]); if (lane == 0) red[r][w] = s; }
    __syncthreads();
    if (tid < 64) { const int r = tid >> 4, j = tid & 15; SS2[(size_t)(t0 + r) * 16 + j] = (j == 0) ? red[r][0] + red[r][1] + red[r][2] + red[r][3] : 0.f; }
}

__global__ void __launch_bounds__(256) nk5_up(const float* __restrict__ X1, const float* __restrict__ SS2, const float* __restrict__ fnw, const float* __restrict__ w_up,
        const float* __restrict__ conv_w, const float* __restrict__ conv_b, bf16_t* __restrict__ ACT) {
    __shared__ float h2[10][1024];
    const int t0 = blockIdx.x * 8, s0 = t0 % SEQ, tid = threadIdx.x, w = tid >> 6, lane = tid & 63;
    for (int r = w; r < 10; r += 4) {
        const int t = t0 - 2 + r; const bool ok = (s0 + r - 2) >= 0;
        float rs = 0.f;
        if (ok) { float s = 0.f; for (int j = 0; j < 16; ++j) s += SS2[(size_t)t * 16 + j]; rs = rsqrtf(s * (1.0f / 1024) + EPS); }
        for (int j = 0; j < 16; ++j) { const int c = lane + 64 * j; h2[r][c] = ok ? X1[(size_t)t * 1024 + c] * rs * fnw[c] : 0.f; }
    }
    __syncthreads();
    for (int f = tid; f < FF; f += 256) {
        float ag[10], av[10];
#pragma unroll
        for (int r = 0; r < 10; ++r) { ag[r] = 0.f; av[r] = 0.f; }
        for (int k = 0; k < 1024; ++k) {
            const float wg = w_up[(size_t)k * FF2 + f], wv = w_up[(size_t)k * FF2 + FF + f];
#pragma unroll
            for (int r = 0; r < 10; ++r) { const float hv = h2[r][k]; ag[r] += hv * wg; av[r] += hv * wv; }
        }
        const float g0 = conv_w[f], g1 = conv_w[FF2 + f], g2 = conv_w[2 * FF2 + f], gb = conv_b[f];
        const float v0 = conv_w[FF + f], v1 = conv_w[FF2 + FF + f], v2 = conv_w[2 * FF2 + FF + f], vb = conv_b[FF + f];
#pragma unroll
        for (int r = 2; r < 10; ++r) {
            const float cg = gb + g0 * ag[r - 2] + g1 * ag[r - 1] + g2 * ag[r];
            const float cv = vb + v0 * av[r - 2] + v1 * av[r - 1] + v2 * av[r];
            ACT[(size_t)(t0 + r - 2) * FF + f] = f2bf(cg / (1.0f + expf(-cg)) * cv);
        }
    }
}

__global__ void __launch_bounds__(256) nk6_down(const bf16_t* __restrict__ ACT, const float* __restrict__ w_down, float* __restrict__ X, float* __restrict__ SS3) {
    __shared__ float a[4][FF];
    __shared__ float red[4][4];
    const int t0 = blockIdx.x * 4, tid = threadIdx.x, w = tid >> 6, lane = tid & 63;
    for (int i = tid; i < 4 * FF; i += 256) a[i / FF][i % FF] = bf2f(ACT[(size_t)t0 * FF + i]);
    __syncthreads();
    float ss[4] = {0.f, 0.f, 0.f, 0.f};
    for (int c = tid; c < 1024; c += 256) {
        float a0 = 0.f, a1 = 0.f, a2 = 0.f, a3 = 0.f;
        for (int k = 0; k < FF; ++k) { const float wv = w_down[(size_t)k * 1024 + c]; a0 += a[0][k] * wv; a1 += a[1][k] * wv; a2 += a[2][k] * wv; a3 += a[3][k] * wv; }
        float v[4] = {a0, a1, a2, a3};
#pragma unroll
        for (int r = 0; r < 4; ++r) { const float x2 = X[(size_t)(t0 + r) * 1024 + c] + v[r]; X[(size_t)(t0 + r) * 1024 + c] = x2; ss[r] += x2 * x2; }
    }
#pragma unroll
    for (int r = 0; r < 4; ++r) { const float s = wave_sum(ss[r]); if (lane == 0) red[r][w] = s; }
    __syncthreads();
    if (tid < 64) { const int r = tid >> 4, j = tid & 15; SS3[(size_t)(t0 + r) * 16 + j] = (j == 0) ? red[r][0] + red[r][1] + red[r][2] + red[r][3] : 0.f; }
}

__global__ void __launch_bounds__(256) nk7_final(float* __restrict__ X, const float* __restrict__ SS3, const float* __restrict__ fw) {
    const int t = blockIdx.x * 4 + (threadIdx.x >> 6), lane = threadIdx.x & 63;
    float s = 0.f;
#pragma unroll
    for (int j = 0; j < 16; ++j) s += SS3[(size_t)t * 16 + j];
    const float rs = rsqrtf(s * (1.0f / 1024) + EPS);
    float4* xr = (float4*)(X + (size_t)t * 1024) + lane; const float4* wr = (const float4*)fw + lane;
#pragma unroll
    for (int j = 0; j < 4; ++j) { float4 v = xr[64 * j]; const float4 g = wr[64 * j]; v.x *= rs * g.x; v.y *= rs * g.y; v.z *= rs * g.z; v.w *= rs * g.w; xr[64 * j] = v; }
}

extern "C" void kernel_launch(void* const* d_in, const int* in_sizes, int n_in, void* d_out, int out_size, void* d_ws, size_t ws_size, hipStream_t stream) {
    static int inited = 0;
    if (!inited) {
        if (n_in != 16 || in_sizes[0] != NT * DM || out_size != NT * DM || ws_size < WS_END) { fprintf(stderr, "kernel_launch: unexpected shapes (n_in %d, ws %zu)\n", n_in, ws_size); inited = -1; return; }
        (void)hipFuncSetAttribute((const void*)nk3_out, hipFuncAttributeMaxDynamicSharedMemorySize, NK3O_LDS);
        inited = 1;
    }
    if (inited < 0) return;
    const float* x = (const float*)d_in[0]; const int* pos = (const int*)d_in[1];
    const float* attn_nw = (const float*)d_in[2]; const float* w_in = (const float*)d_in[3]; const float* gnw = (const float*)d_in[4];
    const float* qnw = (const float*)d_in[5]; const float* w_uq = (const float*)d_in[6]; const float* kvnw = (const float*)d_in[7]; const float* w_ukv = (const float*)d_in[8];
    const float* w_out = (const float*)d_in[9]; const float* fnw = (const float*)d_in[10]; const float* w_up = (const float*)d_in[11];
    const float* conv_w = (const float*)d_in[12]; const float* conv_b = (const float*)d_in[13]; const float* w_down = (const float*)d_in[14]; const float* final_w = (const float*)d_in[15];
    unsigned char* ws = (unsigned char*)d_ws; float* out = (float*)d_out;
    float2* rt_ret = (float2*)(ws + WS_RTRET); float2* rt_mla = (float2*)(ws + WS_RTMLA);
    bf16_t *RQ = (bf16_t*)(ws + WS_RQ), *RK = (bf16_t*)(ws + WS_RK), *RV = (bf16_t*)(ws + WS_RV), *RG = (bf16_t*)(ws + WS_RG);
    bf16_t *CQ = (bf16_t*)(ws + WS_CQ), *CKV = (bf16_t*)(ws + WS_CKV), *KPE = (bf16_t*)(ws + WS_KPE), *QB = (bf16_t*)(ws + WS_QB), *KVB = (bf16_t*)(ws + WS_KVB);
    bf16_t *MIX = (bf16_t*)(ws + WS_MIX), *X1B = (bf16_t*)(ws + WS_X1B), *ACT = (bf16_t*)(ws + WS_ACT);
    float *SSQ = (float*)(ws + WS_SSQ), *SSKV = (float*)(ws + WS_SSKV), *SS2 = (float*)(ws + WS_SS2), *SS3 = (float*)(ws + WS_SS3), *NS = (float*)(ws + WS_NS);

    k_tables<<<NT * 48 / 256, 256, 0, stream>>>(pos, rt_ret, rt_mla);
    nk1_inproj<<<NT / 4, 256, 0, stream>>>(x, attn_nw, w_in, rt_ret, rt_mla, RQ, RK, RV, RG, CQ, CKV, KPE, SSQ, SSKV);
    nk2_mlaup<<<NT / 4, 256, 0, stream>>>(CQ, CKV, SSQ, SSKV, qnw, w_uq, kvnw, w_ukv, rt_mla, QB, KVB);
    nk3_states<<<2048, 256, 0, stream>>>(RK, RV, NS);
    nk3_scan<<<131072 / 256, 256, 0, stream>>>(NS);
    nk3_out<<<2048, 256, NK3O_LDS, stream>>>(RQ, RK, RV, RG, NS, gnw, MIX);
    nk3_attn<<<32 * 1024, 512, 0, stream>>>(QB, KVB, KPE, MIX);
    nk4_outproj<<<NT / 4, 256, 0, stream>>>(x, MIX, w_out, out, X1B, SS2);
    nk5_up<<<NT / 8, 256, 0, stream>>>(out, SS2, fnw, w_up, conv_w, conv_b, ACT);
    nk6_down<<<NT / 4, 256, 0, stream>>>(ACT, w_down, out, SS3);
    nk7_final<<<NT / 4, 256, 0, stream>>>(out, SS3, final_w);
}
```

```cpp
#include <hip/hip_runtime.h>
#include <cstdint>
#include <cstdio>

constexpr int NB = 4, SEQ = 8192, NT = NB * SEQ, DM = 1024;
constexpr int INW = 2464, FF = 2816, FF2 = 5632;
constexpr int SEQP = 8448;
constexpr float EPS = 1e-6f;
constexpr float QSCALE = 0.10206207261596577f * 1.4426950408889634f;

typedef unsigned short bf16_t;
__device__ __forceinline__ float bf2f(bf16_t v) { return __uint_as_float(((unsigned)v) << 16); }
__device__ __forceinline__ bf16_t f2bf(float f) { unsigned u = __float_as_uint(f); return (bf16_t)((u + 0x7fffu + ((u >> 16) & 1u)) >> 16); }
__device__ __forceinline__ float wave_sum(float v) {
#pragma unroll
    for (int o = 1; o < 64; o <<= 1) v += __shfl_xor(v, o);
    return v;
}
__device__ __forceinline__ float wave_max(float v) {
#pragma unroll
    for (int o = 1; o < 64; o <<= 1) v = fmaxf(v, __shfl_xor(v, o));
    return v;
}

constexpr size_t MiB = 1u << 20;
constexpr size_t WS_CTL = 0;
constexpr size_t WS_RS1 = 1 * MiB;
constexpr size_t WS_SSQ = 1 * MiB + 512 * 1024;
constexpr size_t WS_SSKV = 2 * MiB;
constexpr size_t WS_SS2 = 3 * MiB;
constexpr size_t WS_SS3 = 5 * MiB;
constexpr size_t WS_RTRET = 8 * MiB;
constexpr size_t WS_RTMLA = 16 * MiB;
constexpr size_t WS_WIN = 20 * MiB, WS_WUQ = 25 * MiB, WS_WUKV = 25 * MiB + 512 * 1024, WS_WOUT = 26 * MiB, WS_WUP = 28 * MiB, WS_WDOWN = 39 * MiB;
constexpr size_t WS_XB = 48 * MiB;
constexpr size_t WS_X1B = 48 * MiB;
constexpr size_t WS_RQ = 114 * MiB, WS_RK = 146 * MiB, WS_RV = 178 * MiB, WS_RG = 210 * MiB;
constexpr size_t WS_CQ = 242 * MiB, WS_CKV = 258 * MiB, WS_KPE = 266 * MiB;
constexpr size_t WS_QB = 268 * MiB, WS_KVB = 316 * MiB;
constexpr size_t WS_NS = 380 * MiB;
constexpr size_t WS_MIX = 412 * MiB;
constexpr size_t WS_ACT = 114 * MiB;
constexpr size_t WS_END = 476 * MiB;

__global__ void __launch_bounds__(256) k_tables(const int* __restrict__ pos, float2* __restrict__ rt_ret, float2* __restrict__ rt_mla) {
    const int idx = blockIdx.x * 256 + threadIdx.x;
    if (idx >= NT * 48) return;
    const int t = idx / 48, j = idx % 48;
    const bool mla = j >= 32; const int i = mla ? j - 32 : j;
    const double ex = mla ? -(double)i / 16.0 : -(double)i / 32.0;
    const float inv = (float)exp2(ex * 13.287712379549449);
    const float ang = (float)pos[t] * inv;
    const double a = (double)ang;
    const double n = rint(a * 0.6366197723675814);
    const double r = a - n * 1.5707963267948966;
    const double r2 = r * r;
    const double sn = r + r * r2 * (-1.0 / 6 + r2 * (1.0 / 120 + r2 * (-1.0 / 5040 + r2 * (1.0 / 362880 - r2 / 39916800.0))));
    const double cs = 1.0 + r2 * (-0.5 + r2 * (1.0 / 24 + r2 * (-1.0 / 720 + r2 * (1.0 / 40320 + r2 * (-1.0 / 3628800 + r2 / 479001600.0)))));
    const int q = ((int)n) & 3;
    float c, s;
    if (q == 0) { c = (float)cs; s = (float)sn; } else if (q == 1) { c = (float)-sn; s = (float)cs; } else if (q == 2) { c = (float)-cs; s = (float)-sn; } else { c = (float)sn; s = (float)-cs; }
    if (mla) rt_mla[t * 16 + i] = make_float2(c, s); else rt_ret[t * 32 + i] = make_float2(c, s);
}

__global__ void __launch_bounds__(256) nk1_inproj(const float* __restrict__ x, const float* __restrict__ nw, const float* __restrict__ w_in,
        const float2* __restrict__ rt_ret, const float2* __restrict__ rt_mla,
        bf16_t* RQ, bf16_t* RK, bf16_t* RV, bf16_t* RG, bf16_t* CQ, bf16_t* CKV, bf16_t* KPE, float* SSQ, float* SSKV) {
    __shared__ float h[4][1024];
    __shared__ float pr[4][INW];
    const int t0 = blockIdx.x * 4, tid = threadIdx.x, w = tid >> 6, lane = tid & 63;
    {
        const float* xr = x + (size_t)(t0 + w) * DM; float v[16]; float s = 0.f;
#pragma unroll
        for (int j = 0; j < 16; ++j) { v[j] = xr[lane + 64 * j]; s += v[j] * v[j]; }
        s = wave_sum(s); const float rs = rsqrtf(s * (1.0f / DM) + EPS);
#pragma unroll
        for (int j = 0; j < 16; ++j) h[w][lane + 64 * j] = v[j] * rs * nw[lane + 64 * j];
    }
    __syncthreads();
    for (int c = tid; c < INW; c += 256) {
        float a0 = 0.f, a1 = 0.f, a2 = 0.f, a3 = 0.f;
        for (int k = 0; k < DM; ++k) { const float wv = w_in[(size_t)k * INW + c]; a0 += h[0][k] * wv; a1 += h[1][k] * wv; a2 += h[2][k] * wv; a3 += h[3][k] * wv; }
        pr[0][c] = a0; pr[1][c] = a1; pr[2][c] = a2; pr[3][c] = a3;
    }
    __syncthreads();
    for (int idx = tid; idx < 4 * INW; idx += 256) {
        const int r = idx / INW, c = idx % INW; const int t = t0 + r; const float v = pr[r][c];
        if (c < 1024) {
            const int cc = c & 511, i = cc & 63, f = i & 31; const float2 cs = rt_ret[(size_t)t * 32 + f];
            const float x1 = pr[r][c - i + f], x2 = pr[r][c - i + f + 32];
            const float o = (i < 32) ? x1 * cs.x - x2 * cs.y : x1 * cs.y + x2 * cs.x;
            if (c < 512) RQ[(size_t)t * 512 + cc] = f2bf(o); else RK[(size_t)t * 512 + cc] = f2bf(o * 0.125f);
        } else if (c < 1536) RV[(size_t)t * 512 + c - 1024] = f2bf(v);
        else if (c < 2048) RG[(size_t)t * 512 + c - 1536] = f2bf(v);
        else if (c < 2304) CQ[(size_t)t * 256 + c - 2048] = f2bf(v);
        else if (c < 2432) CKV[(size_t)t * 128 + c - 2304] = f2bf(v);
        else { const int i = c - 2432, f = i & 15; const float2 cs = rt_mla[(size_t)t * 16 + f];
            const float x1 = pr[r][2432 + f], x2 = pr[r][2432 + f + 16];
            const float o = (i < 16) ? x1 * cs.x - x2 * cs.y : x1 * cs.y + x2 * cs.x;
            KPE[(size_t)t * 32 + i] = f2bf(o); }
    }
    {
        const int t = t0 + w; float s = 0.f;
#pragma unroll
        for (int j = 0; j < 4; ++j) { const float v = pr[w][2048 + lane + 64 * j]; s += v * v; }
        s = wave_sum(s);
        float s2 = 0.f;
#pragma unroll
        for (int j = 0; j < 2; ++j) { const float v = pr[w][2304 + lane + 64 * j]; s2 += v * v; }
        s2 = wave_sum(s2);
        if (lane == 0) { SSQ[t * 4] = s; SSQ[t * 4 + 1] = 0.f; SSQ[t * 4 + 2] = 0.f; SSQ[t * 4 + 3] = 0.f; SSKV[t * 4] = s2; SSKV[t * 4 + 1] = 0.f; SSKV[t * 4 + 2] = 0.f; SSKV[t * 4 + 3] = 0.f; }
    }
}

__global__ void __launch_bounds__(256) nk2_mlaup(const bf16_t* __restrict__ CQ, const bf16_t* __restrict__ CKV, const float* __restrict__ SSQ, const float* __restrict__ SSKV,
        const float* __restrict__ qnw, const float* __restrict__ w_uq, const float* __restrict__ kvnw, const float* __restrict__ w_ukv,
        const float2* __restrict__ rt_mla, bf16_t* QB, bf16_t* KVB) {
    __shared__ float cq[4][256];
    __shared__ float ckv[4][128];
    __shared__ float q[4][768];
    const int t0 = blockIdx.x * 4, tid = threadIdx.x, w = tid >> 6, lane = tid & 63;
    {
        const int t = t0 + w;
        const float rsq = rsqrtf((SSQ[t * 4] + SSQ[t * 4 + 1] + SSQ[t * 4 + 2] + SSQ[t * 4 + 3]) * (1.0f / 256) + EPS);
        const float rskv = rsqrtf((SSKV[t * 4] + SSKV[t * 4 + 1] + SSKV[t * 4 + 2] + SSKV[t * 4 + 3]) * (1.0f / 128) + EPS);
#pragma unroll
        for (int j = 0; j < 4; ++j) cq[w][lane + 64 * j] = bf2f(CQ[(size_t)t * 256 + lane + 64 * j]) * rsq * qnw[lane + 64 * j];
#pragma unroll
        for (int j = 0; j < 2; ++j) ckv[w][lane + 64 * j] = bf2f(CKV[(size_t)t * 128 + lane + 64 * j]) * rskv * kvnw[lane + 64 * j];
    }
    __syncthreads();
    for (int c = tid; c < 768; c += 256) {
        float a0 = 0.f, a1 = 0.f, a2 = 0.f, a3 = 0.f;
        for (int k = 0; k < 256; ++k) { const float wv = w_uq[(size_t)k * 768 + c]; a0 += cq[0][k] * wv; a1 += cq[1][k] * wv; a2 += cq[2][k] * wv; a3 += cq[3][k] * wv; }
        q[0][c] = a0; q[1][c] = a1; q[2][c] = a2; q[3][c] = a3;
    }
    for (int c = tid; c < 1024; c += 256) {
        float a0 = 0.f, a1 = 0.f, a2 = 0.f, a3 = 0.f;
        for (int k = 0; k < 128; ++k) { const float wv = w_ukv[(size_t)k * 1024 + c]; a0 += ckv[0][k] * wv; a1 += ckv[1][k] * wv; a2 += ckv[2][k] * wv; a3 += ckv[3][k] * wv; }
        KVB[(size_t)(t0 + 0) * 1024 + c] = f2bf(a0); KVB[(size_t)(t0 + 1) * 1024 + c] = f2bf(a1); KVB[(size_t)(t0 + 2) * 1024 + c] = f2bf(a2); KVB[(size_t)(t0 + 3) * 1024 + c] = f2bf(a3);
    }
    __syncthreads();
    for (int idx = tid; idx < 4 * 768; idx += 256) {
        const int r = idx / 768, c = idx % 768, t = t0 + r; const int hd = c / 96, d = c % 96; float o;
        if (d < 64) o = q[r][c];
        else { const int i = d - 64, f = i & 15; const float2 cs = rt_mla[(size_t)t * 16 + f];
            const float x1 = q[r][hd * 96 + 64 + f], x2 = q[r][hd * 96 + 64 + f + 16];
            o = (i < 16) ? x1 * cs.x - x2 * cs.y : x1 * cs.y + x2 * cs.x; }
        QB[(size_t)t * 768 + c] = f2bf(o * QSCALE);
    }
}

__device__ __forceinline__ float ret_lg(int h) { return log1pf(-exp2f(-5.0f - (float)h)); }
__global__ void __launch_bounds__(256) nk3_states(const bf16_t* __restrict__ RK, const bf16_t* __restrict__ RV, float* __restrict__ NS) {
    __shared__ bf16_t ks[128][64];
    __shared__ bf16_t vs[128][64];
    const int u = blockIdx.x, n = u & 63, bh = u >> 6, h = bh & 7, b = bh >> 3, tid = threadIdx.x;
    const size_t tb = (size_t)b * SEQ + (size_t)n * 128;
    for (int i = tid; i < 128 * 64; i += 256) { const int j = i >> 6, d = i & 63; ks[j][d] = RK[(tb + j) * 512 + h * 64 + d]; vs[j][d] = RV[(tb + j) * 512 + h * 64 + d]; }
    __syncthreads();
    const float lg = ret_lg(h);
    float acc[16];
#pragma unroll
    for (int i = 0; i < 16; ++i) acc[i] = 0.f;
    for (int j = 0; j < 128; ++j) {
        const float z = expf(lg * (127.0f - (float)j));
#pragma unroll
        for (int i = 0; i < 16; ++i) { const int idx = tid + 256 * i, d = idx >> 6, e = idx & 63; acc[i] += bf2f(ks[j][d]) * z * bf2f(vs[j][e]); }
    }
#pragma unroll
    for (int i = 0; i < 16; ++i) NS[(size_t)u * 4096 + tid + 256 * i] = acc[i];
}
__global__ void __launch_bounds__(256) nk3_scan(float* __restrict__ NS) {
    const int g = blockIdx.x * 256 + threadIdx.x; const int bh = g >> 12, el = g & 4095, h = bh & 7;
    const float cd = expf(ret_lg(h) * 128.0f);
    float R = 0.f;
    for (int n = 0; n < 64; ++n) { float* p = NS + ((size_t)(bh * 64 + n)) * 4096 + el; const float s = *p; *p = R; R = cd * R + s; }
}
constexpr int NK3O_LDS = 3 * 16384 + 16384 + 64 * 129 * 4 + 64 * 65 * 4;
__global__ void __launch_bounds__(256) nk3_out(const bf16_t* __restrict__ RQ, const bf16_t* __restrict__ RK, const bf16_t* __restrict__ RV, const bf16_t* __restrict__ RG,
        const float* __restrict__ NS, const float* __restrict__ gnw, bf16_t* __restrict__ MIX) {
    extern __shared__ __attribute__((aligned(16))) unsigned char smem[];
    bf16_t (*qs)[64] = (bf16_t(*)[64])smem;
    bf16_t (*ks)[64] = (bf16_t(*)[64])(smem + 16384);
    bf16_t (*vs)[64] = (bf16_t(*)[64])(smem + 32768);
    float (*Rp)[64] = (float(*)[64])(smem + 49152);
    float (*sc)[129] = (float(*)[129])(smem + 65536);
    float (*ob)[65] = (float(*)[65])(smem + 65536 + 64 * 129 * 4);
    const int u = blockIdx.x, n = u & 63, bh = u >> 6, h = bh & 7, b = bh >> 3, tid = threadIdx.x, w = tid >> 6, lane = tid & 63;
    const size_t tb = (size_t)b * SEQ + (size_t)n * 128;
    for (int i = tid; i < 128 * 64; i += 256) { const int j = i >> 6, d = i & 63; const size_t o = (tb + j) * 512 + h * 64 + d; qs[j][d] = RQ[o]; ks[j][d] = RK[o]; vs[j][d] = RV[o]; }
    for (int i = tid; i < 4096; i += 256) Rp[i >> 6][i & 63] = NS[(size_t)u * 4096 + i];
    __syncthreads();
    const float lg = ret_lg(h);
    for (int half = 0; half < 2; ++half) {
        const int i0 = half * 64;
        for (int it = 0; it < 32; ++it) {
            const int idx = tid + 256 * it, i = idx >> 7, j = idx & 127, ig = i0 + i; float v = 0.f;
            if (j <= ig) { float a = 0.f;
                for (int d = 0; d < 64; ++d) a += bf2f(qs[ig][d]) * bf2f(ks[j][d]);
                v = a * expf(lg * (float)(ig - j)); }
            sc[i][j] = v;
        }
        __syncthreads();
        for (int it = 0; it < 16; ++it) {
            const int idx = tid + 256 * it, i = idx >> 6, e = idx & 63, ig = i0 + i; float a = 0.f;
            for (int j = 0; j <= ig; ++j) a += sc[i][j] * bf2f(vs[j][e]);
            float c = 0.f;
            for (int d = 0; d < 64; ++d) c += bf2f(qs[ig][d]) * Rp[d][e];
            ob[i][e] = a + c * expf(lg * (float)(ig + 1));
        }
        __syncthreads();
        for (int rr = 0; rr < 16; ++rr) {
            const int i = w * 16 + rr, ig = i0 + i; const size_t t = tb + ig;
            const float v = ob[i][lane]; const float mu = wave_sum(v) * (1.0f / 64); const float dv = v - mu; const float var = wave_sum(dv * dv) * (1.0f / 64);
            const float y = dv * rsqrtf(var + EPS) * gnw[h * 64 + lane];
            const float g = bf2f(RG[t * 512 + h * 64 + lane]);
            MIX[t * 1024 + h * 64 + lane] = f2bf(g / (1.0f + expf(-g)) * y);
        }
        __syncthreads();
    }
}

__global__ void __launch_bounds__(512) nk3_attn(const bf16_t* __restrict__ QB, const bf16_t* __restrict__ KVB, const bf16_t* __restrict__ KPE, bf16_t* __restrict__ MIX) {
    __shared__ __attribute__((aligned(16))) bf16_t kt[64][104];
    __shared__ __attribute__((aligned(16))) bf16_t vt[64][64];
    __shared__ float qv[8][96];
    __shared__ float ps[8][64];
    const int tid = threadIdx.x, w = tid >> 6, lane = tid & 63;
    const int bh = blockIdx.x >> 10, sblk = blockIdx.x & 1023, b = bh >> 3, h = bh & 7;
    const int s = sblk * 8 + w; const size_t t = (size_t)b * SEQ + s;
    for (int d = lane; d < 96; d += 64) qv[w][d] = bf2f(QB[t * 768 + h * 96 + d]);
    float m = -INFINITY, l = 0.f, o = 0.f;
    const int ntile = (sblk * 8 + 7) / 64 + 1;
    for (int kb = 0; kb < ntile; ++kb) {
        __syncthreads();
        {
            const int r = tid >> 3, c = tid & 7; const size_t tk = (size_t)b * SEQ + kb * 64 + r;
            *(uint4*)&kt[r][c * 8] = *(const uint4*)&KVB[tk * 1024 + h * 128 + c * 8];
            *(uint4*)&vt[r][c * 8] = *(const uint4*)&KVB[tk * 1024 + h * 128 + 64 + c * 8];
            if (tid < 256) { const int r2 = tid >> 2, c2 = tid & 3; const size_t tk2 = (size_t)b * SEQ + kb * 64 + r2; *(uint4*)&kt[r2][64 + c2 * 8] = *(const uint4*)&KPE[tk2 * 32 + c2 * 8]; }
        }
        __syncthreads();
        const int key = kb * 64 + lane; const bool valid = key <= s;
        float a = 0.f;
        for (int d = 0; d < 96; ++d) a += qv[w][d] * bf2f(kt[lane][d]);
        const float scv = valid ? a : -INFINITY;
        const float mn = fmaxf(m, wave_max(scv));
        const float p = valid ? exp2f(a - mn) : 0.f;
        const float alpha = exp2f(m - mn);
        l = l * alpha + wave_sum(p);
        ps[w][lane] = p;
        __builtin_amdgcn_s_waitcnt(0);
        float acc = 0.f;
        for (int j = 0; j < 64; ++j) acc += ps[w][j] * bf2f(vt[j][lane]);
        o = o * alpha + acc; m = mn;
    }
    MIX[t * 1024 + 512 + h * 64 + lane] = f2bf(o / l);
}

__device__ __forceinline__ size_t prow(int t) { const int b = t / SEQ, s = t % SEQ; return (size_t)b * SEQP + 2 + s; }
__global__ void __launch_bounds__(256) nk4_outproj(const float* __restrict__ x, const bf16_t* __restrict__ MIX, const float* __restrict__ w_out,
        float* __restrict__ X1, bf16_t* __restrict__ X1B, float* __restrict__ SS2) {
    __shared__ float mx[4][1024];
    __shared__ float red[4][4];
    const int t0 = blockIdx.x * 4, tid = threadIdx.x, w = tid >> 6, lane = tid & 63;
    for (int i = tid; i < 4096; i += 256) mx[i >> 10][i & 1023] = bf2f(MIX[(size_t)t0 * 1024 + i]);
    if ((t0 % SEQ) == 0) { const int b = t0 / SEQ; for (int i = tid; i < 2048; i += 256) X1B[(size_t)b * SEQP * 1024 + i] = 0; }
    __syncthreads();
    float ss[4] = {0.f, 0.f, 0.f, 0.f};
    for (int c = tid; c < 1024; c += 256) {
        float a0 = 0.f, a1 = 0.f, a2 = 0.f, a3 = 0.f;
        for (int k = 0; k < 1024; ++k) { const float wv = w_out[(size_t)k * 1024 + c]; a0 += mx[0][k] * wv; a1 += mx[1][k] * wv; a2 += mx[2][k] * wv; a3 += mx[3][k] * wv; }
        float v[4] = {a0, a1, a2, a3};
#pragma unroll
        for (int r = 0; r < 4; ++r) { const float x1 = x[(size_t)(t0 + r) * 1024 + c] + v[r]; X1[(size_t)(t0 + r) * 1024 + c] = x1; X1B[prow(t0 + r) * 1024 + c] = f2bf(x1); ss[r] += x1 * x1; }
    }
#pragma unroll
    for (int r = 0; r < 4; ++r) { const float s = wave_sum(ss[r]); if (lane == 0) red[r][w] = s; }
    __syncthreads();
    if (tid < 64) { const int r = tid >> 4, j = tid & 15; SS2[(size_t)(t0 + r) * 16 + j] = (j == 0) ? red[r][0] + red[r][1] + red[r][2] + red[r][3] : 0.f; }
}

__global__ void __launch_bounds__(256) nk5_up(const float* __restrict__ X1, const float* __restrict__ SS2, const float* __restrict__ fnw, const float* __restrict__ w_up,
        const float* __restrict__ conv_w, const float* __restrict__ conv_b, bf16_t* __restrict__ ACT) {
    __shared__ float h2[10][1024];
    const int t0 = blockIdx.x * 8, s0 = t0 % SEQ, tid = threadIdx.x, w = tid >> 6, lane = tid & 63;
    for (int r = w; r < 10; r += 4) {
        const int t = t0 - 2 + r; const bool ok = (s0 + r - 2) >= 0;
        float rs = 0.f;
        if (ok) { float s = 0.f; for (int j = 0; j < 16; ++j) s += SS2[(size_t)t * 16 + j]; rs = rsqrtf(s * (1.0f / 1024) + EPS); }
        for (int j = 0; j < 16; ++j) { const int c = lane + 64 * j; h2[r][c] = ok ? X1[(size_t)t * 1024 + c] * rs * fnw[c] : 0.f; }
    }
    __syncthreads();
    for (int f = tid; f < FF; f += 256) {
        float ag[10], av[10];
#pragma unroll
        for (int r = 0; r < 10; ++r) { ag[r] = 0.f; av[r] = 0.f; }
        for (int k = 0; k < 1024; ++k) {
            const float wg = w_up[(size_t)k * FF2 + f], wv = w_up[(size_t)k * FF2 + FF + f];
#pragma unroll
            for (int r = 0; r < 10; ++r) { const float hv = h2[r][k]; ag[r] += hv * wg; av[r] += hv * wv; }
        }
        const float g0 = conv_w[f], g1 = conv_w[FF2 + f], g2 = conv_w[2 * FF2 + f], gb = conv_b[f];
        const float v0 = conv_w[FF + f], v1 = conv_w[FF2 + FF + f], v2 = conv_w[2 * FF2 + FF + f], vb = conv_b[FF + f];
#pragma unroll
        for (int r = 2; r < 10; ++r) {
            const float cg = gb + g0 * ag[r - 2] + g1 * ag[r - 1] + g2 * ag[r];
            const float cv = vb + v0 * av[r - 2] + v1 * av[r - 1] + v2 * av[r];
            ACT[(size_t)(t0 + r - 2) * FF + f] = f2bf(cg / (1.0f + expf(-cg)) * cv);
        }
    }
}

__global__ void __launch_bounds__(256) nk6_down(const bf16_t* __restrict__ ACT, const float* __restrict__ w_down, float* __restrict__ X, float* __restrict__ SS3) {
    __shared__ float a[4][FF];
    __shared__ float red[4][4];
    const int t0 = blockIdx.x * 4, tid = threadIdx.x, w = tid >> 6, lane = tid & 63;
    for (int i = tid; i < 4 * FF; i += 256) a[i / FF][i % FF] = bf2f(ACT[(size_t)t0 * FF + i]);
    __syncthreads();
    float ss[4] = {0.f, 0.f, 0.f, 0.f};
    for (int c = tid; c < 1024; c += 256) {
        float a0 = 0.f, a1 = 0.f, a2 = 0.f, a3 = 0.f;
        for (int k = 0; k < FF; ++k) { const float wv = w_down[(size_t)k * 1024 + c]; a0 += a[0][k] * wv; a1 += a[1][k] * wv; a2 += a[2][k] * wv; a3 += a[3][k] * wv; }
        float v[4] = {a0, a1, a2, a3};
#pragma unroll
        for (int r = 0; r < 4; ++r) { const float x2 = X[(size_t)(t0 + r) * 1024 + c] + v[r]; X[(size_t)(t0 + r) * 1024 + c] = x2; ss[r] += x2 * x2; }
    }
#pragma unroll
    for (int r = 0; r < 4; ++r) { const float s = wave_sum(ss[r]); if (lane == 0) red[r][w] = s; }
    __syncthreads();
    if (tid < 64) { const int r = tid >> 4, j = tid & 15; SS3[(size_t)(t0 + r) * 16 + j] = (j == 0) ? red[r][0] + red[r][1] + red[r][2] + red[r][3] : 0.f; }
}

__global__ void __launch_bounds__(256) nk7_final(float* __restrict__ X, const float* __restrict__ SS3, const float* __restrict__ fw) {
    const int t = blockIdx.x * 4 + (threadIdx.x >> 6), lane = threadIdx.x & 63;
    float s = 0.f;
#pragma unroll
    for (int j = 0; j < 16; ++j) s += SS3[(size_t)t * 16 + j];
    const float rs = rsqrtf(s * (1.0f / 1024) + EPS);
    float4* xr = (float4*)(X + (size_t)t * 1024) + lane; const float4* wr = (const float4*)fw + lane;
#pragma unroll
    for (int j = 0; j < 4; ++j) { float4 v = xr[64 * j]; const float4 g = wr[64 * j]; v.x *= rs * g.x; v.y *= rs * g.y; v.z *= rs * g.z; v.w *= rs * g.w; xr[64 * j] = v; }
}

#define LAS __attribute__((address_space(3)))
#define GAS __attribute__((address_space(1)))
typedef short bf16x8 __attribute__((ext_vector_type(8)));
typedef float f32x4 __attribute__((ext_vector_type(4)));
typedef float f32x2 __attribute__((ext_vector_type(2)));
typedef unsigned u32x4 __attribute__((ext_vector_type(4)));
typedef unsigned u32x2 __attribute__((ext_vector_type(2)));
typedef __bf16 bf16x2_t __attribute__((ext_vector_type(2)));
__device__ __forceinline__ unsigned pk2(float lo, float hi) { f32x2 v = {lo, hi}; bf16x2_t b = __builtin_convertvector(v, bf16x2_t); return __builtin_bit_cast(unsigned, b); }

namespace pg8 {
constexpr int BM = 256, BK = 64, HALF = 128, HTB = HALF * BK * 2, STAGE_BYTES = 8 * HTB, NXCD = 8, WGM = 8;
__host__ __device__ __forceinline__ int lds_byte(int r, int c) { const int st = (r >> 4) * 2 + (c >> 5), rr = r & 15, cc = c & 31, ob = rr * 64 + cc * 2; return st * 1024 + (ob ^ (((ob >> 9) & 1) << 5)); }
__host__ __device__ __forceinline__ void stage_rc(int b, int& R, int& C) { const int st = b / 1024, sb = b % 1024, swz = sb ^ (((sb >> 9) & 1) << 5); R = (st >> 1) * 16 + swz / 64; C = (st & 1) * 32 + (swz % 64) / 2; }
__host__ __device__ __forceinline__ int perm32(int rho) { const int n = rho >> 4, i = rho & 15; return 8 * (i >> 2) + 4 * n + (i & 3); }
struct Unit { int pm, pn; };
struct Gemm { const bf16_t* A; const bf16_t* Bt; int nM, nN, K; int amode; };
__device__ __forceinline__ const char* a_tile(const Gemm& g, int pm) {
    if (g.amode == 0) return (const char*)g.A + (size_t)pm * 256 * g.K * 2;
    const int b = pm / 33, i = pm - b * 33; return (const char*)g.A + ((size_t)b * SEQP + (size_t)254 * i) * g.K * 2;
}
struct StaticOrder {
    int nM, nN, nwg, G, c;
    __device__ void init(int nM_, int nN_, int G_, int c_) { nM = nM_; nN = nN_; nwg = nM * nN; G = G_; c = c_; }
    __device__ bool next(int i, Unit& u) const {
        const long L = (long)i * G + c; if (L >= nwg) return false;
        int wgid = (int)L; { const int q = nwg / NXCD, r = nwg % NXCD, xcd = wgid % NXCD, off = wgid / NXCD; wgid = (xcd < r ? xcd * (q + 1) : r * (q + 1) + (xcd - r) * q) + off; }
        const int nig = WGM * nN, gid = wgid / nig, fm = gid * WGM, gsz = (nM - fm) < WGM ? (nM - fm) : WGM;
        u.pm = fm + ((wgid % nig) % gsz); u.pn = (wgid % nig) / gsz; return true;
    }
};

template <class Epi, bool ALIGN_EPI, bool SP2>
__device__ __forceinline__ void gemm_phase(LAS unsigned char* lds, const Gemm g, const StaticOrder& S, const Epi& E) {
    int tid_ = threadIdx.x; asm volatile("" : "+v"(tid_));
    const int tid = tid_, wid = __builtin_amdgcn_readfirstlane(tid >> 6), lane = tid & 63, wr = wid >> 2, wc = wid & 3, fr = lane & 15, fq = lane >> 4;
    const int K = g.K, nt = K / BK;
    unsigned voffA[2], voffB[2];
#pragma unroll
    for (int i = 0; i < 2; ++i) { int R, C; stage_rc(tid * 16 + i * 8192, R, C); const int Rb = (R & ~31) + perm32(R & 31);
        voffA[i] = (unsigned)(R * K + C) * 2u; voffB[i] = (unsigned)(Rb * K + C) * 2u; }
    const size_t kstep = (size_t)(BK * 2);
    const size_t hstep = (size_t)HALF * K * 2;
    const size_t tstep = 2 * hstep;
    const unsigned ldsw = (unsigned)wid * 1024u;
    const int aoff = lds_byte(wr * 64 + fr, fq * 8), boff = lds_byte(wc * 32 + fr, fq * 8);
#define PG8_SA(b, h) (((b) * 2 + (h)) * HTB)
#define PG8_SB(b, h) ((4 + (b) * 2 + (h)) * HTB)
#define PG8_STAGE(bufoff, gbase, voff) do { _Pragma("unroll") for (int _i = 0; _i < 2; ++_i) \
        __builtin_amdgcn_global_load_lds((const unsigned*)((const char*)(gbase) + (voff)[_i]), (LAS unsigned*)(lds + (bufoff) + ldsw + _i * 8192), 16, 0, 0); } while (0)
#define PG8_LDA(dst, b, h) do { _Pragma("unroll") for (int m = 0; m < 4; ++m) _Pragma("unroll") for (int k = 0; k < 2; ++k) dst[m][k] = *(const LAS bf16x8*)(lds + PG8_SA(b, h) + aoff + m * 2048 + k * 1024); } while (0)
#define PG8_LDB(dst, b, h) do { _Pragma("unroll") for (int n = 0; n < 2; ++n) _Pragma("unroll") for (int k = 0; k < 2; ++k) dst[n][k] = *(const LAS bf16x8*)(lds + PG8_SB(b, h) + boff + n * 2048 + k * 1024); } while (0)
#define PG8_MMA(ai, bj, At, Bt) do { __builtin_amdgcn_s_setprio(1); _Pragma("unroll") for (int m = 0; m < 4; ++m) _Pragma("unroll") for (int n = 0; n < 2; ++n) _Pragma("unroll") for (int k = 0; k < 2; ++k) \
        acc[ai][bj][m][n] = __builtin_amdgcn_mfma_f32_16x16x32_bf16(Bt[n][k], At[m][k], acc[ai][bj][m][n], 0, 0, 0); __builtin_amdgcn_s_setprio(0); } while (0)
#define PG8_WAIT_V(n) asm volatile("s_waitcnt vmcnt(" #n ")" ::: "memory")
#define PG8_WAIT_L(n) asm volatile("s_waitcnt lgkmcnt(" #n ")" ::: "memory")
#define PG8_BAR __builtin_amdgcn_s_barrier()
#define PG8_SCHED __builtin_amdgcn_sched_barrier(0)
    Unit cur, nxt; int ui = 0;
    if (!S.next(0, cur)) return;
    f32x4 acc[2][2][4][2];
#pragma unroll
    for (int a = 0; a < 2; ++a)
#pragma unroll
        for (int b = 0; b < 2; ++b)
#pragma unroll
            for (int m = 0; m < 4; ++m)
#pragma unroll
                for (int n = 0; n < 2; ++n) acc[a][b][m][n] = (f32x4){0.f, 0.f, 0.f, 0.f};
    bf16x8 At[4][2], B0[2][2], B1[2][2];
    const char* cA = a_tile(g, cur.pm); const char* cB = (const char*)g.Bt + (size_t)cur.pn * tstep;
    if constexpr (SP2) {
        PG8_STAGE(PG8_SB(0, 0), cB, voffB); PG8_STAGE(PG8_SB(0, 1), cB + hstep, voffB); PG8_STAGE(PG8_SA(0, 0), cA, voffA); PG8_STAGE(PG8_SA(0, 1), cA + hstep, voffA);
        if (wr == 1) PG8_BAR;
        PG8_WAIT_V(2); PG8_BAR;
        PG8_STAGE(PG8_SB(1, 0), cB + kstep, voffB); PG8_STAGE(PG8_SA(1, 0), cA + kstep, voffA); PG8_STAGE(PG8_SB(1, 1), cB + hstep + kstep, voffB);
        PG8_WAIT_V(6); PG8_BAR;
    } else {
        PG8_STAGE(PG8_SB(0, 0), cB, voffB); PG8_STAGE(PG8_SA(0, 0), cA, voffA); PG8_STAGE(PG8_SB(0, 1), cB + hstep, voffB); PG8_STAGE(PG8_SA(0, 1), cA + hstep, voffA);
        if (wr == 1) PG8_BAR;
        PG8_WAIT_V(4); PG8_BAR;
        PG8_STAGE(PG8_SB(1, 0), cB + kstep, voffB); PG8_STAGE(PG8_SA(1, 0), cA + kstep, voffA); PG8_STAGE(PG8_SB(1, 1), cB + hstep + kstep, voffB);
        PG8_WAIT_V(6); PG8_BAR;
    }
    for (;;) {
        const bool has_next = S.next(ui + 1, nxt);
        const char* nA = has_next ? a_tile(g, nxt.pm) : cA; const char* nB = has_next ? (const char*)g.Bt + (size_t)nxt.pn * tstep : cB;
        for (int t = 0; t < nt; t += 2) {
            const bool last = (t == nt - 2);
            const char* a1 = cA + (size_t)(t + 1) * kstep;
            const char* a2 = last ? nA : cA + (size_t)(t + 2) * kstep; const char* b2 = last ? nB : cB + (size_t)(t + 2) * kstep;
            const char* a3 = a2 + kstep; const char* b3 = b2 + kstep;
            if constexpr (SP2) {
            PG8_LDB(B0, 0, 0); PG8_LDB(B1, 0, 1); PG8_SCHED; PG8_LDA(At, 0, 0); PG8_STAGE(PG8_SA(1, 1), a1 + hstep, voffA);
            PG8_WAIT_V(8); PG8_WAIT_L(0); PG8_BAR; PG8_MMA(0, 0, At, B0); PG8_MMA(0, 1, At, B1); PG8_BAR; PG8_SCHED;
            PG8_LDA(At, 0, 1); PG8_STAGE(PG8_SB(0, 0), b2, voffB); PG8_STAGE(PG8_SB(0, 1), b2 + hstep, voffB); PG8_STAGE(PG8_SA(0, 0), a2, voffA);
            PG8_WAIT_V(8); PG8_WAIT_L(0); PG8_BAR; PG8_MMA(1, 0, At, B0); PG8_MMA(1, 1, At, B1); PG8_BAR; PG8_SCHED;
            PG8_LDB(B0, 1, 0); PG8_LDB(B1, 1, 1); PG8_SCHED; PG8_LDA(At, 1, 0); PG8_STAGE(PG8_SA(0, 1), a2 + hstep, voffA);
            PG8_WAIT_V(8); PG8_WAIT_L(0); PG8_BAR; PG8_MMA(0, 0, At, B0); PG8_MMA(0, 1, At, B1); PG8_BAR; PG8_SCHED;
            PG8_LDA(At, 1, 1); PG8_STAGE(PG8_SB(1, 0), b3, voffB); PG8_STAGE(PG8_SB(1, 1), b3 + hstep, voffB); PG8_STAGE(PG8_SA(1, 0), a3, voffA);
            PG8_WAIT_V(8); PG8_WAIT_L(0); PG8_BAR; PG8_MMA(1, 0, At, B0); PG8_MMA(1, 1, At, B1); PG8_BAR; PG8_SCHED;
            } else {
            PG8_LDB(B0, 0, 0); PG8_SCHED; PG8_LDA(At, 0, 0); PG8_STAGE(PG8_SA(1, 1), a1 + hstep, voffA);
            PG8_WAIT_L(8); PG8_BAR; PG8_WAIT_L(0); PG8_MMA(0, 0, At, B0); PG8_BAR; PG8_SCHED;
            PG8_LDB(B1, 0, 1); PG8_STAGE(PG8_SB(0, 0), b2, voffB);
            PG8_BAR; PG8_WAIT_L(0); PG8_MMA(0, 1, At, B1); PG8_BAR;
            PG8_LDA(At, 0, 1); PG8_STAGE(PG8_SA(0, 0), a2, voffA);
            PG8_BAR; PG8_WAIT_L(0); PG8_MMA(1, 0, At, B0); PG8_BAR; PG8_SCHED;
            PG8_STAGE(PG8_SB(0, 1), b2 + hstep, voffB);
            PG8_WAIT_V(6); PG8_BAR; PG8_MMA(1, 1, At, B1); PG8_BAR;
            PG8_LDB(B0, 1, 0); PG8_SCHED; PG8_LDA(At, 1, 0); PG8_STAGE(PG8_SA(0, 1), a2 + hstep, voffA);
            PG8_WAIT_L(8); PG8_BAR; PG8_WAIT_L(0); PG8_MMA(0, 0, At, B0); PG8_BAR; PG8_SCHED;
            PG8_LDB(B1, 1, 1); PG8_STAGE(PG8_SB(1, 0), b3, voffB);
            PG8_BAR; PG8_WAIT_L(0); PG8_MMA(0, 1, At, B1); PG8_BAR;
            PG8_LDA(At, 1, 1); PG8_STAGE(PG8_SA(1, 0), a3, voffA);
            PG8_BAR; PG8_WAIT_L(0); PG8_MMA(1, 0, At, B0); PG8_BAR; PG8_SCHED;
            PG8_STAGE(PG8_SB(1, 1), b3 + hstep, voffB);
            PG8_WAIT_V(6); PG8_BAR; PG8_MMA(1, 1, At, B1); PG8_BAR;
            }
        }
        if constexpr (ALIGN_EPI) { if (wr == 0) PG8_BAR; }
        E(acc, cur, wr, wc, fr, fq);
        if (!has_next) break;
#pragma unroll
        for (int a = 0; a < 2; ++a)
#pragma unroll
            for (int b = 0; b < 2; ++b)
#pragma unroll
                for (int m = 0; m < 4; ++m)
#pragma unroll
                    for (int n = 0; n < 2; ++n) acc[a][b][m][n] = (f32x4){0.f, 0.f, 0.f, 0.f};
        cur = nxt; cA = nA; cB = nB; ++ui;
        if constexpr (ALIGN_EPI) { if (wr == 1) PG8_BAR; }
    }
    PG8_WAIT_V(0);
    if constexpr (!ALIGN_EPI) { if (wr == 0) PG8_BAR; }
    PG8_BAR;
#undef PG8_SA
#undef PG8_SB
#undef PG8_STAGE
#undef PG8_LDA
#undef PG8_LDB
#undef PG8_MMA
#undef PG8_WAIT_V
#undef PG8_WAIT_L
#undef PG8_BAR
#undef PG8_SCHED
}

typedef f32x4 Acc[2][2][4][2];
__device__ __forceinline__ float quad_sum(float s) { s += __shfl_xor(s, 16); s += __shfl_xor(s, 32); return s; }
__device__ __forceinline__ u32x4 pack8(f32x4 a, f32x4 b) { u32x4 w; w.x = pk2(a[0], a[1]); w.y = pk2(a[2], a[3]); w.z = pk2(b[0], b[1]); w.w = pk2(b[2], b[3]); return w; }

struct EpiInProj {
    unsigned char* ws;
    __device__ __forceinline__ void operator()(Acc& acc, const Unit& u, int wr, int wc, int fr, int fq) const {
        const int pn = u.pn; const int row0 = u.pm * 256 + wr * 64 + fr;
        bf16_t *RQ = (bf16_t*)(ws + WS_RQ), *RK = (bf16_t*)(ws + WS_RK), *RV = (bf16_t*)(ws + WS_RV), *RG = (bf16_t*)(ws + WS_RG), *CQ = (bf16_t*)(ws + WS_CQ), *CKV = (bf16_t*)(ws + WS_CKV), *KPE = (bf16_t*)(ws + WS_KPE);
        const float* rs1 = (const float*)(ws + WS_RS1); float *SSQ = (float*)(ws + WS_SSQ), *SSKV = (float*)(ws + WS_SSKV); const float2 *rt_ret = (const float2*)(ws + WS_RTRET), *rt_mla = (const float2*)(ws + WS_RTMLA);
        if (pn < 4) {
            bf16_t* dst = pn < 2 ? RQ : RK; const float ks = pn < 2 ? 1.f : 0.125f; const int hc = (4 * (pn & 1) + wc) * 64 + 8 * fq;
#pragma unroll
            for (int ai = 0; ai < 2; ++ai)
#pragma unroll
                for (int m = 0; m < 4; ++m) {
                    const int t = row0 + ai * 128 + m * 16; const float rs = rs1[t] * ks;
                    const f32x4* tp = (const f32x4*)(rt_ret + (size_t)t * 32 + 8 * fq);
                    f32x4 o1[2], o2[2];
#pragma unroll
                    for (int n = 0; n < 2; ++n) { const f32x4 cA = tp[2 * n], cB = tp[2 * n + 1]; const f32x4 x1 = acc[ai][0][m][n] * rs, x2 = acc[ai][1][m][n] * rs;
                        o1[n][0] = x1[0] * cA[0] - x2[0] * cA[1]; o2[n][0] = x1[0] * cA[1] + x2[0] * cA[0];
                        o1[n][1] = x1[1] * cA[2] - x2[1] * cA[3]; o2[n][1] = x1[1] * cA[3] + x2[1] * cA[2];
                        o1[n][2] = x1[2] * cB[0] - x2[2] * cB[1]; o2[n][2] = x1[2] * cB[1] + x2[2] * cB[0];
                        o1[n][3] = x1[3] * cB[2] - x2[3] * cB[3]; o2[n][3] = x1[3] * cB[3] + x2[3] * cB[2]; }
                    *(u32x4*)(dst + (size_t)t * 512 + hc) = pack8(o1[0], o1[1]);
                    *(u32x4*)(dst + (size_t)t * 512 + hc + 32) = pack8(o2[0], o2[1]);
                }
        } else if (pn < 8) {
            bf16_t* dst = pn < 6 ? RV : RG; const int cb = (pn & 1) * 256 + wc * 32 + 8 * fq;
#pragma unroll
            for (int ai = 0; ai < 2; ++ai)
#pragma unroll
                for (int m = 0; m < 4; ++m) { const int t = row0 + ai * 128 + m * 16; const float rs = rs1[t];
#pragma unroll
                    for (int bj = 0; bj < 2; ++bj) *(u32x4*)(dst + (size_t)t * 512 + cb + bj * 128) = pack8(acc[ai][bj][m][0] * rs, acc[ai][bj][m][1] * rs); }
        } else if (pn == 8) {
#pragma unroll
            for (int ai = 0; ai < 2; ++ai)
#pragma unroll
                for (int m = 0; m < 4; ++m) { const int t = row0 + ai * 128 + m * 16; const float rs = rs1[t]; float ss = 0.f;
#pragma unroll
                    for (int bj = 0; bj < 2; ++bj) { const f32x4 a = acc[ai][bj][m][0] * rs, b = acc[ai][bj][m][1] * rs;
                        ss += (a[0] * a[0] + a[1] * a[1]) + (a[2] * a[2] + a[3] * a[3]) + (b[0] * b[0] + b[1] * b[1]) + (b[2] * b[2] + b[3] * b[3]);
                        *(u32x4*)(CQ + (size_t)t * 256 + bj * 128 + wc * 32 + 8 * fq) = pack8(a, b); }
                    ss = quad_sum(ss); if (fq == 0) SSQ[(size_t)t * 4 + wc] = ss; }
        } else {
#pragma unroll
            for (int ai = 0; ai < 2; ++ai)
#pragma unroll
                for (int m = 0; m < 4; ++m) { const int t = row0 + ai * 128 + m * 16; const float rs = rs1[t];
                    const f32x4 a = acc[ai][0][m][0] * rs, b = acc[ai][0][m][1] * rs;
                    float ss = (a[0] * a[0] + a[1] * a[1]) + (a[2] * a[2] + a[3] * a[3]) + (b[0] * b[0] + b[1] * b[1]) + (b[2] * b[2] + b[3] * b[3]);
                    *(u32x4*)(CKV + (size_t)t * 128 + wc * 32 + 8 * fq) = pack8(a, b);
                    ss = quad_sum(ss); if (fq == 0) SSKV[(size_t)t * 4 + wc] = ss;
                    if (wc == 0) { const f32x4* tp = (const f32x4*)(rt_mla + (size_t)t * 16 + 4 * fq); const f32x4 cA = tp[0], cB = tp[1];
                        const f32x4 x1 = acc[ai][1][m][0] * rs, x2 = acc[ai][1][m][1] * rs; f32x4 o1, o2;
                        o1[0] = x1[0] * cA[0] - x2[0] * cA[1]; o2[0] = x1[0] * cA[1] + x2[0] * cA[0];
                        o1[1] = x1[1] * cA[2] - x2[1] * cA[3]; o2[1] = x1[1] * cA[3] + x2[1] * cA[2];
                        o1[2] = x1[2] * cB[0] - x2[2] * cB[1]; o2[2] = x1[2] * cB[1] + x2[2] * cB[0];
                        o1[3] = x1[3] * cB[2] - x2[3] * cB[3]; o2[3] = x1[3] * cB[3] + x2[3] * cB[2];
                        u32x2 w1, w2; w1.x = pk2(o1[0], o1[1]); w1.y = pk2(o1[2], o1[3]); w2.x = pk2(o2[0], o2[1]); w2.y = pk2(o2[2], o2[3]);
                        *(u32x2*)(KPE + (size_t)t * 32 + 4 * fq) = w1; *(u32x2*)(KPE + (size_t)t * 32 + 16 + 4 * fq) = w2; }
                }
        }
    }
};

struct EpiQUp {
    unsigned char* ws;
    __device__ __forceinline__ void operator()(Acc& acc, const Unit& u, int wr, int wc, int fr, int fq) const {
        const int pn = u.pn; const int row0 = u.pm * 256 + wr * 64 + fr;
        bf16_t* QB = (bf16_t*)(ws + WS_QB); const float* SSQ = (const float*)(ws + WS_SSQ); const float2* rt_mla = (const float2*)(ws + WS_RTMLA);
        if (pn < 2) {
#pragma unroll
            for (int ai = 0; ai < 2; ++ai)
#pragma unroll
                for (int m = 0; m < 4; ++m) { const int t = row0 + ai * 128 + m * 16;
                    const f32x4 p = *(const f32x4*)(SSQ + (size_t)t * 4); const float rs = rsqrtf(((p[0] + p[1]) + (p[2] + p[3])) * (1.0f / 256) + EPS) * QSCALE;
#pragma unroll
                    for (int bj = 0; bj < 2; ++bj) { const int c = pn * 256 + bj * 128 + wc * 32 + 8 * fq; const int hd = c >> 6, d = c & 63;
                        *(u32x4*)(QB + (size_t)t * 768 + hd * 96 + d) = pack8(acc[ai][bj][m][0] * rs, acc[ai][bj][m][1] * rs); }
                    if (m & 1) asm volatile("" ::: "memory"); }
        } else {
#pragma unroll
            for (int ai = 0; ai < 2; ++ai)
#pragma unroll
                for (int m = 0; m < 4; ++m) { const int t = row0 + ai * 128 + m * 16;
                    const f32x4 p = *(const f32x4*)(SSQ + (size_t)t * 4); const float rs = rsqrtf(((p[0] + p[1]) + (p[2] + p[3])) * (1.0f / 256) + EPS) * QSCALE;
                    const f32x4* tp = (const f32x4*)(rt_mla + (size_t)t * 16 + 4 * fq); const f32x4 cA = tp[0], cB = tp[1];
#pragma unroll
                    for (int bj = 0; bj < 2; ++bj) { const int hd = 4 * bj + wc; const f32x4 x1 = acc[ai][bj][m][0] * rs, x2 = acc[ai][bj][m][1] * rs; f32x4 o1, o2;
                        o1[0] = x1[0] * cA[0] - x2[0] * cA[1]; o2[0] = x1[0] * cA[1] + x2[0] * cA[0];
                        o1[1] = x1[1] * cA[2] - x2[1] * cA[3]; o2[1] = x1[1] * cA[3] + x2[1] * cA[2];
                        o1[2] = x1[2] * cB[0] - x2[2] * cB[1]; o2[2] = x1[2] * cB[1] + x2[2] * cB[0];
                        o1[3] = x1[3] * cB[2] - x2[3] * cB[3]; o2[3] = x1[3] * cB[3] + x2[3] * cB[2];
                        u32x2 w1, w2; w1.x = pk2(o1[0], o1[1]); w1.y = pk2(o1[2], o1[3]); w2.x = pk2(o2[0], o2[1]); w2.y = pk2(o2[2], o2[3]);
                        *(u32x2*)(QB + (size_t)t * 768 + hd * 96 + 64 + 4 * fq) = w1; *(u32x2*)(QB + (size_t)t * 768 + hd * 96 + 80 + 4 * fq) = w2; }
                    asm volatile("" ::: "memory"); }
        }
    }
};
struct EpiKVUp {
    unsigned char* ws;
    __device__ __forceinline__ void operator()(Acc& acc, const Unit& u, int wr, int wc, int fr, int fq) const {
        bf16_t* KVB = (bf16_t*)(ws + WS_KVB); const float* SSKV = (const float*)(ws + WS_SSKV);
        const int row0 = u.pm * 256 + wr * 64 + fr, c0 = u.pn * 256 + wc * 32 + 8 * fq;
#pragma unroll
        for (int ai = 0; ai < 2; ++ai)
#pragma unroll
            for (int m = 0; m < 4; ++m) { const int t = row0 + ai * 128 + m * 16;
                const f32x4 p = *(const f32x4*)(SSKV + (size_t)t * 4); const float rs = rsqrtf(((p[0] + p[1]) + (p[2] + p[3])) * (1.0f / 128) + EPS);
#pragma unroll
                for (int bj = 0; bj < 2; ++bj) *(u32x4*)(KVB + (size_t)t * 1024 + c0 + bj * 128) = pack8(acc[ai][bj][m][0] * rs, acc[ai][bj][m][1] * rs); }
    }
};
template <bool WRITE_BF> struct EpiResid {
    const float* base; float* out; unsigned char* ws;
    __device__ __forceinline__ void operator()(Acc& acc, const Unit& u, int wr, int wc, int fr, int fq) const {
        bf16_t* X1B = (bf16_t*)(ws + WS_X1B); float* SS = (float*)(ws + (WRITE_BF ? WS_SS2 : WS_SS3));
        const int row0 = u.pm * 256 + wr * 64 + fr, c0 = u.pn * 256 + wc * 32 + 8 * fq;
#pragma unroll
        for (int ai = 0; ai < 2; ++ai)
#pragma unroll
            for (int m = 0; m < 4; ++m) { const int t = row0 + ai * 128 + m * 16; float ss = 0.f;
#pragma unroll
                for (int bj = 0; bj < 2; ++bj) { const size_t off = (size_t)t * 1024 + c0 + bj * 128;
                    const f32x4 a = *(const f32x4*)(base + off) + acc[ai][bj][m][0], b = *(const f32x4*)(base + off + 4) + acc[ai][bj][m][1];
                    *(f32x4*)(out + off) = a; *(f32x4*)(out + off + 4) = b;
                    ss += (a[0] * a[0] + a[1] * a[1]) + (a[2] * a[2] + a[3] * a[3]) + (b[0] * b[0] + b[1] * b[1]) + (b[2] * b[2] + b[3] * b[3]);
                    if (WRITE_BF) { const size_t pr = (size_t)(t >> 13) * SEQP + 2 + (t & 8191); *(u32x4*)(X1B + pr * 1024 + c0 + bj * 128) = pack8(a, b); } }
                ss = quad_sum(ss); if (fq == 0) SS[(size_t)t * 16 + u.pn * 4 + wc] = ss; }
    }
};
template <int CTRL> __device__ __forceinline__ float dppf(float old, float src) { return __builtin_bit_cast(float, __builtin_amdgcn_update_dpp(__builtin_bit_cast(int, old), __builtin_bit_cast(int, src), CTRL, 0xf, 0xf, false)); }
struct EpiUpConv {
    unsigned char* ws; const float* conv_w; const float* conv_b; LAS unsigned char* xch;
    __device__ __forceinline__ void operator()(Acc& acc, const Unit& u, int wr, int wc, int fr, int fq) const {
        const float* SS2 = (const float*)(ws + WS_SS2); bf16_t* ACT = (bf16_t*)(ws + WS_ACT);
        const int b = u.pm / 33, ti = u.pm - b * 33, sb = 254 * ti - 2;
#pragma unroll
        for (int ai = 0; ai < 2; ++ai)
#pragma unroll
            for (int m = 0; m < 4; ++m) { const int s = sb + ai * 128 + wr * 64 + m * 16 + fr; const bool ok = (s >= 0) && (s < SEQ);
                f32x4 p = {0.f, 0.f, 0.f, 0.f}; if (ok) p = *(const f32x4*)(SS2 + ((size_t)b * SEQ + s) * 16 + 4 * fq);
                const float sum = quad_sum((p[0] + p[1]) + (p[2] + p[3])); const float rs = ok ? rsqrtf(sum * (1.0f / 1024) + EPS) : 0.f;
#pragma unroll
                for (int bj = 0; bj < 2; ++bj)
#pragma unroll
                    for (int n = 0; n < 2; ++n) acc[ai][bj][m][n] = ok ? acc[ai][bj][m][n] * rs : (f32x4){0.f, 0.f, 0.f, 0.f}; }
        if (fr >= 14) {
#pragma unroll
            for (int ai = 0; ai < 2; ++ai)
#pragma unroll
                for (int bj = 0; bj < 2; ++bj)
#pragma unroll
                    for (int n = 0; n < 2; ++n) *(LAS f32x4*)(xch + ((((2 * ai + wr) * 2 + (fr - 14)) * 256) + bj * 128 + wc * 32 + 8 * fq + 4 * n) * 4) = acc[ai][bj][3][n];
        }
        asm volatile("s_waitcnt lgkmcnt(0)" ::: "memory"); __builtin_amdgcn_s_barrier(); asm volatile("" ::: "memory");
        const int f0 = u.pn * 128 + wc * 32 + 8 * fq;
#pragma unroll
        for (int n = 0; n < 2; ++n) {
            const int f = f0 + 4 * n;
            const f32x4 g0 = *(const f32x4*)(conv_w + f), g1 = *(const f32x4*)(conv_w + FF2 + f), g2 = *(const f32x4*)(conv_w + 2 * FF2 + f), gb = *(const f32x4*)(conv_b + f);
            const f32x4 v0 = *(const f32x4*)(conv_w + FF + f), v1 = *(const f32x4*)(conv_w + FF2 + FF + f), v2 = *(const f32x4*)(conv_w + 2 * FF2 + FF + f), vb = *(const f32x4*)(conv_b + FF + f);
#pragma unroll
            for (int ai = 0; ai < 2; ++ai) {
                const int blk = 2 * ai + wr;
                f32x4 pg = {0.f, 0.f, 0.f, 0.f}, pv = {0.f, 0.f, 0.f, 0.f};
                if (blk >= 1 && fr >= 14) { const LAS unsigned char* xp = xch + ((((blk - 1) * 2 + (fr - 14)) * 256) + wc * 32 + 8 * fq + 4 * n) * 4;
                    pg = *(const LAS f32x4*)xp; pv = *(const LAS f32x4*)(xp + 128 * 4); }
#pragma unroll
                for (int m = 0; m < 4; ++m) {
                    const f32x4 cg = acc[ai][0][m][n], cv = acc[ai][1][m][n];
                    f32x4 og, ov;
#pragma unroll
                    for (int e = 0; e < 4; ++e) {
                        const float g_1 = dppf<0x111>(dppf<0x121>(0.f, pg[e]), cg[e]), g_2 = dppf<0x112>(dppf<0x122>(0.f, pg[e]), cg[e]);
                        const float v_1 = dppf<0x111>(dppf<0x121>(0.f, pv[e]), cv[e]), v_2 = dppf<0x112>(dppf<0x122>(0.f, pv[e]), cv[e]);
                        og[e] = gb[e] + g0[e] * g_2 + g1[e] * g_1 + g2[e] * cg[e];
                        ov[e] = vb[e] + v0[e] * v_2 + v1[e] * v_1 + v2[e] * cv[e];
                    }
                    const int r = ai * 128 + wr * 64 + m * 16 + fr, s = sb + r;
                    if (r >= 2 && s < SEQ) {
                        f32x4 a;
#pragma unroll
                        for (int e = 0; e < 4; ++e) a[e] = og[e] * __builtin_amdgcn_rcpf(1.0f + __builtin_amdgcn_exp2f(-1.4426950408889634f * og[e])) * ov[e];
                        u32x2 w; w.x = pk2(a[0], a[1]); w.y = pk2(a[2], a[3]);
                        *(u32x2*)(ACT + ((size_t)b * SEQ + s) * FF + f) = w;
                    }
                    pg = cg; pv = cv;
                }
            }
        }
    }
};
}

#define LDS_WAIT() asm volatile("s_waitcnt lgkmcnt(0)" ::: "memory")
#define VM_WAIT() asm volatile("s_waitcnt vmcnt(0)" ::: "memory")
#define XB_TMO      128
#define XB_XCNT(j)  (256  + 64 * (j))
#define XB_XSUB(j)  (1280 + 64 * (j))
#define XB_XGEN(j)  (2304 + 64 * (j))
#define XB_TOP      3328
#define XB_TOPGEN   3392
#define XCD_BAR_WORDS 3456
#define XB_SPIN_CAP (1u << 18)
__device__ __forceinline__ unsigned xb_ld(unsigned* p)              { return __hip_atomic_load(p, __ATOMIC_RELAXED, __HIP_MEMORY_SCOPE_AGENT); }
__device__ __forceinline__ unsigned xb_add(unsigned* p, unsigned v) { return __hip_atomic_fetch_add(p, v, __ATOMIC_RELAXED, __HIP_MEMORY_SCOPE_AGENT); }
__device__ __forceinline__ unsigned xb_xcc_id() { return (unsigned)__builtin_amdgcn_s_getreg((3 << 11) | 20) & 0xFu; }
#define XB_SPIN(cond, bar) do { unsigned _sp = 0; while (cond) { __builtin_amdgcn_s_sleep(1); \
    if ((++_sp & 255u) == 0u) { if (xb_ld(&(bar)[XB_TMO])) break; if (_sp > XB_SPIN_CAP) { atomicAdd(&(bar)[XB_TMO], 1u); break; } } } } while (0)
struct XcdBarrier { unsigned* bar; unsigned x; volatile LAS unsigned* st; };
__device__ __forceinline__ XcdBarrier xcd_barrier_post(unsigned* bar, volatile LAS unsigned* st) {
    XcdBarrier b; b.bar = bar; b.x = xb_xcc_id(); b.st = st;
    if (threadIdx.x == 0) (void)xb_add(&bar[XB_XCNT(b.x)], 1u);
    return b;
}
__device__ __forceinline__ void xcd_barrier_complete(unsigned* bar, unsigned x, unsigned& nloc, unsigned& nx) {
    const unsigned G = gridDim.x * gridDim.y * gridDim.z;
    unsigned sum, cnt, mine, sp = 0u;
    for (;;) {
        sum = 0u; cnt = 0u; mine = 0u;
#pragma unroll
        for (unsigned j = 0; j < 16; ++j) { const unsigned c = xb_ld(&bar[XB_XCNT(j)]); sum += c; cnt += (c > 0u) ? 1u : 0u; mine = (j == x) ? c : mine; }
        if (sum == G) break;
        __builtin_amdgcn_s_sleep(1);
        if ((++sp & 255u) == 0u) { if (xb_ld(&bar[XB_TMO])) break; if (sp > XB_SPIN_CAP) { atomicAdd(&bar[XB_TMO], 1u); break; } }
    }
    nloc = mine > 0u ? mine : 1u; nx = cnt > 0u ? cnt : 1u;
}
__device__ __forceinline__ void xcd_barrier(const XcdBarrier& b) {
    asm volatile("s_waitcnt vmcnt(0)" ::: "memory");
    __syncthreads();
    if (threadIdx.x == 0) {
        unsigned* bar = b.bar;
        __builtin_amdgcn_s_waitcnt(0);
        unsigned nloc = b.st[0], nx = b.st[1];
        if (nloc == 0u) { xcd_barrier_complete(bar, b.x, nloc, nx); b.st[0] = nloc; b.st[1] = nx; }
        const unsigned old = xb_add(&bar[XB_XSUB(b.x)], 1u);
        const unsigned gen = old / nloc;
        if (old + 1u == (gen + 1u) * nloc) {
            __builtin_amdgcn_fence(__ATOMIC_RELEASE, "agent");
            asm volatile("s_waitcnt vmcnt(0)" ::: "memory");
            const unsigned og = xb_add(&bar[XB_TOP], 1u);
            const unsigned tg = og / nx;
            if (og + 1u == (tg + 1u) * nx) xb_add(&bar[XB_TOPGEN], 1u);
            else XB_SPIN(xb_ld(&bar[XB_TOPGEN]) == tg, bar);
            __builtin_amdgcn_fence(__ATOMIC_ACQUIRE, "agent");
            xb_add(&bar[XB_XGEN(b.x)], 1u);
            asm volatile("s_waitcnt vmcnt(0)" ::: "memory");
        } else {
            XB_SPIN(xb_ld(&bar[XB_XGEN(b.x)]) == gen, bar);
            __builtin_amdgcn_fence(__ATOMIC_ACQUIRE, "agent");
            asm volatile("s_waitcnt vmcnt(0)" ::: "memory");
        }
    }
    __syncthreads();
}

constexpr int NWAVES = 8;
constexpr int RING_OFF = 0, RING_BYTES = 131072;
constexpr int XCH_OFF = RING_BYTES, XCH_BYTES = 24576;
constexpr int LDSCTL_OFF = XCH_OFF + XCH_BYTES, MISC_OFF = LDSCTL_OFF + 320;
constexpr int MK_LDS_BYTES = 160 * 1024;
static_assert(MISC_OFF + 128 <= MK_LDS_BYTES, "LDS map");
constexpr int CW_BAR = 4096;
constexpr size_t CTL_ZERO_BYTES = 1 * MiB;

struct Args { const void* in[16]; float* out; unsigned char* ws; int ph_lo, ph_hi, li, pad; };

__device__ __forceinline__ int src_win(int n) {
    const int pn = n >> 8, j = n & 255, bj = j >> 7, wc = (j >> 5) & 3, w = j & 31;
    if (pn < 4) return 256 * pn + 64 * wc + 32 * bj + w;
    if (pn < 9) return n;
    if (j < 128) return 2304 + j;
    if (j < 160) return 2432 + 16 * ((w >> 2) & 1) + 4 * (w >> 3) + (w & 3);
    return -1;
}
__device__ __forceinline__ int src_wuq(int n) {
    if (n < 512) return (n >> 6) * 96 + (n & 63);
    const int j = n & 255, bj = j >> 7, wc = (j >> 5) & 3, w = j & 31;
    return (4 * bj + wc) * 96 + 64 + 16 * ((w >> 2) & 1) + 4 * (w >> 3) + (w & 3);
}
__device__ __forceinline__ int src_wup(int n) { const int tile = n >> 8, j = n & 255; return (j >> 7) * FF + tile * 128 + (j & 127); }
template <int WHICH> __device__ __forceinline__ int src_col(int n) { if (WHICH == 0) return src_win(n); if (WHICH == 1) return src_wuq(n); if (WHICH == 2) return src_wup(n); return n; }
template <int WHICH> __device__ __forceinline__ void p0_transpose_item(const float* __restrict__ W, int K, int Nsrc, const float* __restrict__ gain, bf16_t* WT, LAS float* scr, int item, int nblk, int lane) {
    const int kb = item / nblk, nb = item % nblk, k0 = 64 * kb, n0 = 32 * nb;
    const int sc = src_col<WHICH>(n0 + (lane & 31));
#pragma unroll 8
    for (int i = 0; i < 32; ++i) { const int kk = 2 * i + (lane >> 5); float v = 0.f; if (sc >= 0) v = W[(size_t)(k0 + kk) * Nsrc + sc]; if (gain) v *= gain[k0 + kk]; scr[kk * 33 + (lane & 31)] = v; }
    LDS_WAIT(); asm volatile("" ::: "memory");
    const int c = lane & 7;
#pragma unroll
    for (int j = 0; j < 4; ++j) { const int n = (lane >> 3) + 8 * j; const LAS float* s = scr + (8 * c) * 33 + n;
        u32x4 o; o.x = pk2(s[0 * 33], s[1 * 33]); o.y = pk2(s[2 * 33], s[3 * 33]); o.z = pk2(s[4 * 33], s[5 * 33]); o.w = pk2(s[6 * 33], s[7 * 33]);
        *(u32x4*)(WT + (size_t)(n0 + n) * K + k0 + 8 * c) = o; }
    LDS_WAIT(); asm volatile("" ::: "memory");
}
__device__ __forceinline__ void rope_entry(const int* __restrict__ pos, float2* rt_ret, float2* rt_mla, int idx) {
    const int t = idx / 48, j = idx % 48;
    const bool mla = j >= 32; const int i = mla ? j - 32 : j;
    const double ex = mla ? -(double)i / 16.0 : -(double)i / 32.0;
    const float inv = (float)exp2(ex * 13.287712379549449);
    const float ang = (float)pos[t] * inv;
    const double a = (double)ang;
    const double n = rint(a * 0.6366197723675814);
    const double r = a - n * 1.5707963267948966;
    const double r2 = r * r;
    const double sn = r + r * r2 * (-1.0 / 6 + r2 * (1.0 / 120 + r2 * (-1.0 / 5040 + r2 * (1.0 / 362880 - r2 / 39916800.0))));
    const double cs = 1.0 + r2 * (-0.5 + r2 * (1.0 / 24 + r2 * (-1.0 / 720 + r2 * (1.0 / 40320 + r2 * (-1.0 / 3628800 + r2 / 479001600.0)))));
    const int q = ((int)n) & 3;
    float c, s;
    if (q == 0) { c = (float)cs; s = (float)sn; } else if (q == 1) { c = (float)-sn; s = (float)cs; } else if (q == 2) { c = (float)-cs; s = (float)-sn; } else { c = (float)sn; s = (float)-cs; }
    if (mla) rt_mla[t * 16 + i] = make_float2(c, s); else rt_ret[t * 32 + i] = make_float2(c, s);
}

#ifndef OPT_MASK
#define OPT_MASK 0xF7
#endif

__global__ void __launch_bounds__(NWAVES * 64, 2) mk_fwd(Args args) {
    extern __shared__ __attribute__((aligned(16))) unsigned char lds_raw[];
    LAS unsigned char* lds = (LAS unsigned char*)lds_raw;
    volatile LAS unsigned* MISC = (volatile LAS unsigned*)(lds + MISC_OFF);
    const int tid = threadIdx.x;
    const int G = gridDim.x; const int bx = blockIdx.x; const int vcu = (G % 8 == 0) ? (bx % 8) * (G / 8) + bx / 8 : bx;
    unsigned char* ws = args.ws;
    unsigned* ctl = (unsigned*)(ws + WS_CTL);
    for (int u = tid; u < (MK_LDS_BYTES - LDSCTL_OFF) / 4; u += NWAVES * 64) ((LAS unsigned*)(lds + LDSCTL_OFF))[u] = 0u;
    __syncthreads();
    const int lo = args.ph_lo, hi = args.ph_hi;
    XcdBarrier bar; bar.bar = ctl + CW_BAR + args.li * XCD_BAR_WORDS; bar.x = 0; bar.st = nullptr;
    if (hi - lo > 1) bar = xcd_barrier_post(ctl + CW_BAR + args.li * XCD_BAR_WORDS, MISC + 8);
#define IN(k) (lo <= (k) && (k) < hi)
#define SEAM(k) do { if (IN(k) && IN((k) + 1)) xcd_barrier(bar); } while (0)
#define PHASE_IDS() int tidp_ = threadIdx.x; asm volatile("" : "+v"(tidp_)); const int lane = tidp_ & 63, wave = __builtin_amdgcn_readfirstlane(tidp_ >> 6); const int gw = vcu * NWAVES + wave, NGW = G * NWAVES; (void)lane; (void)gw; (void)NGW

    if (IN(0)) {
        PHASE_IDS();
        const float* x = (const float*)args.in[0]; const int* pos = (const int*)args.in[1];
        const float* attn_nw = (const float*)args.in[2]; const float* w_in = (const float*)args.in[3];
        const float* qnw = (const float*)args.in[5]; const float* w_uq = (const float*)args.in[6]; const float* kvnw = (const float*)args.in[7]; const float* w_ukv = (const float*)args.in[8];
        const float* w_out = (const float*)args.in[9]; const float* fnw = (const float*)args.in[10]; const float* w_up = (const float*)args.in[11]; const float* w_down = (const float*)args.in[14];
        float2* rt_ret = (float2*)(ws + WS_RTRET); float2* rt_mla = (float2*)(ws + WS_RTMLA);
        bf16_t *XB = (bf16_t*)(ws + WS_XB), *WIN = (bf16_t*)(ws + WS_WIN), *WUQ = (bf16_t*)(ws + WS_WUQ), *WUKV = (bf16_t*)(ws + WS_WUKV), *WOUT = (bf16_t*)(ws + WS_WOUT), *WUP = (bf16_t*)(ws + WS_WUP), *WDOWN = (bf16_t*)(ws + WS_WDOWN);
        float* RS1 = (float*)(ws + WS_RS1);
        LAS float* scr = (LAS float*)(lds + RING_OFF + wave * 16384);
        constexpr int I_IN = 16 * 80, I_UQ = 4 * 24, I_UKV = 2 * 32, I_OUT = 16 * 32, I_UP = 16 * 176, I_DOWN = 44 * 32;
        constexpr int NITEMS = I_IN + I_UQ + I_UKV + I_OUT + I_UP + I_DOWN;
        for (int it = gw; it < NITEMS; it += NGW) {
            int r = it;
            if (r < I_IN) { p0_transpose_item<0>(w_in, 1024, INW, attn_nw, WIN, scr, r, 80, lane); continue; } r -= I_IN;
            if (r < I_UQ) { p0_transpose_item<1>(w_uq, 256, 768, qnw, WUQ, scr, r, 24, lane); continue; } r -= I_UQ;
            if (r < I_UKV) { p0_transpose_item<3>(w_ukv, 128, 1024, kvnw, WUKV, scr, r, 32, lane); continue; } r -= I_UKV;
            if (r < I_OUT) { p0_transpose_item<3>(w_out, 1024, 1024, nullptr, WOUT, scr, r, 32, lane); continue; } r -= I_OUT;
            if (r < I_UP) { p0_transpose_item<2>(w_up, 1024, FF2, fnw, WUP, scr, r, 176, lane); continue; } r -= I_UP;
            p0_transpose_item<3>(w_down, FF, 1024, nullptr, WDOWN, scr, r, 32, lane);
        }
        for (int m = gw; m < NT; m += NGW) {
            const f32x4* xr = (const f32x4*)(x + (size_t)m * DM) + lane; f32x4 v[4]; float s = 0.f;
#pragma unroll
            for (int j = 0; j < 4; ++j) { v[j] = xr[64 * j]; s += (v[j][0] * v[j][0] + v[j][1] * v[j][1]) + (v[j][2] * v[j][2] + v[j][3] * v[j][3]); }
            s = wave_sum(s); if (lane == 0) RS1[m] = rsqrtf(s * (1.0f / DM) + EPS);
            u32x2* o8 = (u32x2*)(XB + (size_t)m * DM) + lane;
#pragma unroll
            for (int j = 0; j < 4; ++j) { u32x2 w; w.x = pk2(v[j][0], v[j][1]); w.y = pk2(v[j][2], v[j][3]); o8[64 * j] = w; }
        }
        for (int idx = vcu * 512 + tidp_; idx < NT * 48; idx += G * 512) rope_entry(pos, rt_ret, rt_mla, idx);
    }
    SEAM(0);
    if (IN(1)) {
        pg8::Gemm g{(const bf16_t*)(ws + WS_XB), (const bf16_t*)(ws + WS_WIN), 128, 10, 1024, 0}; pg8::StaticOrder S; S.init(128, 10, G, bx);
        pg8::EpiInProj E{ws};
        pg8::gemm_phase<pg8::EpiInProj, true, true>(lds + RING_OFF, g, S, E);
    }
    SEAM(1);
    if (IN(2)) {
        { pg8::Gemm g{(const bf16_t*)(ws + WS_CQ), (const bf16_t*)(ws + WS_WUQ), 128, 3, 256, 0}; pg8::StaticOrder S; S.init(128, 3, G, bx);
          pg8::EpiQUp E{ws};
          pg8::gemm_phase<pg8::EpiQUp, true, true>(lds + RING_OFF, g, S, E); }
        { pg8::Gemm g{(const bf16_t*)(ws + WS_CKV), (const bf16_t*)(ws + WS_WUKV), 128, 4, 128, 0}; pg8::StaticOrder S; S.init(128, 4, G, bx);
          pg8::EpiKVUp E{ws};
          pg8::gemm_phase<pg8::EpiKVUp, true, true>(lds + RING_OFF, g, S, E); }
    }
    SEAM(2);
    SEAM(3);
    if (IN(4)) {
        if (bx < NB) { for (int i = tid; i < 2048 / 8; i += NWAVES * 64) *(u32x4*)((bf16_t*)(ws + WS_X1B) + (size_t)bx * SEQP * 1024 + i * 8) = (u32x4){0u, 0u, 0u, 0u}; }
        pg8::Gemm g{(const bf16_t*)(ws + WS_MIX), (const bf16_t*)(ws + WS_WOUT), 128, 4, 1024, 0}; pg8::StaticOrder S; S.init(128, 4, G, bx);
        pg8::EpiResid<true> E{(const float*)args.in[0], args.out, ws};
        pg8::gemm_phase<pg8::EpiResid<true>, true, true>(lds + RING_OFF, g, S, E);
    }
    SEAM(4);
    if (IN(5)) {
        pg8::Gemm g{(const bf16_t*)(ws + WS_X1B), (const bf16_t*)(ws + WS_WUP), 132, 22, 1024, 1}; pg8::StaticOrder S; S.init(132, 22, G, bx);
        pg8::EpiUpConv E{ws, (const float*)args.in[12], (const float*)args.in[13], lds + XCH_OFF};
        pg8::gemm_phase<pg8::EpiUpConv, true, true>(lds + RING_OFF, g, S, E);
    }
    SEAM(5);
    if (IN(6)) {
        pg8::Gemm g{(const bf16_t*)(ws + WS_ACT), (const bf16_t*)(ws + WS_WDOWN), 128, 4, FF, 0}; pg8::StaticOrder S; S.init(128, 4, G, bx);
        pg8::EpiResid<false> E{args.out, args.out, ws};
        pg8::gemm_phase<pg8::EpiResid<false>, true, true>(lds + RING_OFF, g, S, E);
    }
    SEAM(6);
    if (IN(7)) {
        PHASE_IDS();
        float* out = args.out; const float* final_w = (const float*)args.in[15]; const float* SS3 = (const float*)(ws + WS_SS3);
        for (int m = gw; m < NT; m += NGW) {
            const f32x4* sp = (const f32x4*)(SS3 + (size_t)m * 16); const f32x4 a = sp[0], b = sp[1], c = sp[2], d = sp[3];
            const float s = ((a[0] + a[1]) + (a[2] + a[3])) + ((b[0] + b[1]) + (b[2] + b[3])) + ((c[0] + c[1]) + (c[2] + c[3])) + ((d[0] + d[1]) + (d[2] + d[3]));
            const float rs = rsqrtf(s * (1.0f / 1024) + EPS);
            f32x4* xr = (f32x4*)(out + (size_t)m * DM) + lane; const f32x4* wr = (const f32x4*)final_w + lane;
#pragma unroll
            for (int j = 0; j < 4; ++j) xr[64 * j] = xr[64 * j] * wr[64 * j] * rs;
        }
    }
#undef IN
#undef SEAM
}

extern "C" void kernel_launch(void* const* d_in, const int* in_sizes, int n_in, void* d_out, int out_size, void* d_ws, size_t ws_size, hipStream_t stream) {
    static int grid = 0;
    if (grid == 0) {
        if (n_in != 16 || in_sizes[0] != NT * DM || out_size != NT * DM || ws_size < WS_END) { fprintf(stderr, "kernel_launch: unexpected shapes (n_in %d, ws %zu)\n", n_in, ws_size); grid = -1; return; }
        (void)hipFuncSetAttribute((const void*)nk3_out, hipFuncAttributeMaxDynamicSharedMemorySize, NK3O_LDS);
        if (hipFuncSetAttribute((const void*)mk_fwd, hipFuncAttributeMaxDynamicSharedMemorySize, MK_LDS_BYTES) != hipSuccess) { fprintf(stderr, "kernel_launch: hipFuncSetAttribute(mk_fwd) failed\n"); grid = -1; return; }
        int dev = 0, cus = 0, per_cu = 0;
        (void)hipGetDevice(&dev); (void)hipDeviceGetAttribute(&cus, hipDeviceAttributeMultiprocessorCount, dev);
        if (hipOccupancyMaxActiveBlocksPerMultiprocessor(&per_cu, (const void*)mk_fwd, NWAVES * 64, MK_LDS_BYTES) != hipSuccess || per_cu < 1) { fprintf(stderr, "kernel_launch: occupancy query says %d blocks per CU\n", per_cu); (void)hipGetLastError(); }
        grid = cus > 0 ? cus : 256;
    }
    if (grid < 0) return;
    const float* x = (const float*)d_in[0];
    const float* gnw = (const float*)d_in[4];
    unsigned char* ws = (unsigned char*)d_ws; float* out = (float*)d_out;
    float2* rt_ret = (float2*)(ws + WS_RTRET); float2* rt_mla = (float2*)(ws + WS_RTMLA);
    bf16_t *RQ = (bf16_t*)(ws + WS_RQ), *RK = (bf16_t*)(ws + WS_RK), *RV = (bf16_t*)(ws + WS_RV), *RG = (bf16_t*)(ws + WS_RG);
    bf16_t *CQ = (bf16_t*)(ws + WS_CQ), *CKV = (bf16_t*)(ws + WS_CKV), *KPE = (bf16_t*)(ws + WS_KPE), *QB = (bf16_t*)(ws + WS_QB), *KVB = (bf16_t*)(ws + WS_KVB);
    bf16_t *MIX = (bf16_t*)(ws + WS_MIX), *X1B = (bf16_t*)(ws + WS_X1B), *ACT = (bf16_t*)(ws + WS_ACT);
    float *SSQ = (float*)(ws + WS_SSQ), *SSKV = (float*)(ws + WS_SSKV), *SS2 = (float*)(ws + WS_SS2), *SS3 = (float*)(ws + WS_SS3), *NS = (float*)(ws + WS_NS);

    (void)hipMemsetAsync(ws + WS_CTL, 0, CTL_ZERO_BYTES, stream);
    Args a{};
    for (int i = 0; i < 16; ++i) a.in[i] = d_in[i];
    a.out = out; a.ws = ws;
    int li = 0;
    for (int k = 0; k < 8;) {
        if ((OPT_MASK >> k) & 1) {
            int e = k; while (e < 8 && ((OPT_MASK >> e) & 1)) ++e;
            a.ph_lo = k; a.ph_hi = e; a.li = li++;
            hipLaunchKernelGGL(mk_fwd, dim3(grid), dim3(NWAVES * 64), MK_LDS_BYTES, stream, a);
            k = e; continue;
        }
        switch (k) {
        case 1: nk1_inproj<<<NT / 4, 256, 0, stream>>>(x, (const float*)d_in[2], (const float*)d_in[3], rt_ret, rt_mla, RQ, RK, RV, RG, CQ, CKV, KPE, SSQ, SSKV); break;
        case 2: nk2_mlaup<<<NT / 4, 256, 0, stream>>>(CQ, CKV, SSQ, SSKV, (const float*)d_in[5], (const float*)d_in[6], (const float*)d_in[7], (const float*)d_in[8], rt_mla, QB, KVB); break;
        case 3:
            nk3_states<<<2048, 256, 0, stream>>>(RK, RV, NS);
            nk3_scan<<<131072 / 256, 256, 0, stream>>>(NS);
            nk3_out<<<2048, 256, NK3O_LDS, stream>>>(RQ, RK, RV, RG, NS, gnw, MIX);
            nk3_attn<<<32 * 1024, 512, 0, stream>>>(QB, KVB, KPE, MIX);
            break;
        case 4: nk4_outproj<<<NT / 4, 256, 0, stream>>>(x, MIX, (const float*)d_in[9], out, X1B, SS2); break;
        case 5: nk5_up<<<NT / 8, 256, 0, stream>>>(out, SS2, (const float*)d_in[10], (const float*)d_in[11], (const float*)d_in[12], (const float*)d_in[13], ACT); break;
        case 6: nk6_down<<<NT / 4, 256, 0, stream>>>(ACT, (const float*)d_in[14], out, SS3); break;
        case 7: nk7_final<<<NT / 4, 256, 0, stream>>>(out, SS3, (const float*)d_in[15]); break;
        default: break;
        }
        ++k;
    }
}
```

```cpp
#include <hip/hip_runtime.h>
#include <cstdint>
#include <cstdio>

constexpr int NB = 4, SEQ = 8192, NT = NB * SEQ, DM = 1024;
constexpr int INW = 2464, FF = 2816, FF2 = 5632;
constexpr int SEQP = 8448;
constexpr float EPS = 1e-6f;
constexpr float QSCALE = 0.10206207261596577f * 1.4426950408889634f;

typedef unsigned short bf16_t;
__device__ __forceinline__ float bf2f(bf16_t v) { return __uint_as_float(((unsigned)v) << 16); }
__device__ __forceinline__ bf16_t f2bf(float f) { unsigned u = __float_as_uint(f); return (bf16_t)((u + 0x7fffu + ((u >> 16) & 1u)) >> 16); }
__device__ __forceinline__ float wave_sum(float v) {
#pragma unroll
    for (int o = 1; o < 64; o <<= 1) v += __shfl_xor(v, o);
    return v;
}
__device__ __forceinline__ float wave_max(float v) {
#pragma unroll
    for (int o = 1; o < 64; o <<= 1) v = fmaxf(v, __shfl_xor(v, o));
    return v;
}

constexpr size_t MiB = 1u << 20;
constexpr size_t WS_CTL = 0;
constexpr size_t WS_RS1 = 1 * MiB;
constexpr size_t WS_SSQ = 1 * MiB + 512 * 1024;
constexpr size_t WS_SSKV = 2 * MiB;
constexpr size_t WS_SS2 = 3 * MiB;
constexpr size_t WS_SS3 = 5 * MiB;
constexpr size_t WS_RTRET = 8 * MiB;
constexpr size_t WS_RTMLA = 16 * MiB;
constexpr size_t WS_WIN = 20 * MiB, WS_WUQ = 25 * MiB, WS_WUKV = 25 * MiB + 512 * 1024, WS_WOUT = 26 * MiB, WS_WUP = 28 * MiB, WS_WDOWN = 39 * MiB;
constexpr size_t WS_XB = 48 * MiB;
constexpr size_t WS_X1B = 48 * MiB;
constexpr size_t WS_RQ = 114 * MiB, WS_RK = 146 * MiB, WS_RV = 178 * MiB, WS_RG = 210 * MiB;
constexpr size_t WS_CQ = 242 * MiB, WS_CKV = 258 * MiB, WS_KPE = 266 * MiB;
constexpr size_t WS_QB = 268 * MiB, WS_KVB = 316 * MiB;
constexpr size_t WS_NS = 380 * MiB;
constexpr size_t WS_MIX = 412 * MiB;
constexpr size_t WS_ACT = 114 * MiB;
constexpr size_t WS_GST = 476 * MiB;
constexpr size_t WS_END = 480 * MiB;

__global__ void __launch_bounds__(256) k_tables(const int* __restrict__ pos, float2* __restrict__ rt_ret, float2* __restrict__ rt_mla) {
    const int idx = blockIdx.x * 256 + threadIdx.x;
    if (idx >= NT * 48) return;
    const int t = idx / 48, j = idx % 48;
    const bool mla = j >= 32; const int i = mla ? j - 32 : j;
    const double ex = mla ? -(double)i / 16.0 : -(double)i / 32.0;
    const float inv = (float)exp2(ex * 13.287712379549449);
    const float ang = (float)pos[t] * inv;
    const double a = (double)ang;
    const double n = rint(a * 0.6366197723675814);
    const double r = a - n * 1.5707963267948966;
    const double r2 = r * r;
    const double sn = r + r * r2 * (-1.0 / 6 + r2 * (1.0 / 120 + r2 * (-1.0 / 5040 + r2 * (1.0 / 362880 - r2 / 39916800.0))));
    const double cs = 1.0 + r2 * (-0.5 + r2 * (1.0 / 24 + r2 * (-1.0 / 720 + r2 * (1.0 / 40320 + r2 * (-1.0 / 3628800 + r2 / 479001600.0)))));
    const int q = ((int)n) & 3;
    float c, s;
    if (q == 0) { c = (float)cs; s = (float)sn; } else if (q == 1) { c = (float)-sn; s = (float)cs; } else if (q == 2) { c = (float)-cs; s = (float)-sn; } else { c = (float)sn; s = (float)-cs; }
    if (mla) rt_mla[t * 16 + i] = make_float2(c, s); else rt_ret[t * 32 + i] = make_float2(c, s);
}

__global__ void __launch_bounds__(256) nk1_inproj(const float* __restrict__ x, const float* __restrict__ nw, const float* __restrict__ w_in,
        const float2* __restrict__ rt_ret, const float2* __restrict__ rt_mla,
        bf16_t* RQ, bf16_t* RK, bf16_t* RV, bf16_t* RG, bf16_t* CQ, bf16_t* CKV, bf16_t* KPE, float* SSQ, float* SSKV) {
    __shared__ float h[4][1024];
    __shared__ float pr[4][INW];
    const int t0 = blockIdx.x * 4, tid = threadIdx.x, w = tid >> 6, lane = tid & 63;
    {
        const float* xr = x + (size_t)(t0 + w) * DM; float v[16]; float s = 0.f;
#pragma unroll
        for (int j = 0; j < 16; ++j) { v[j] = xr[lane + 64 * j]; s += v[j] * v[j]; }
        s = wave_sum(s); const float rs = rsqrtf(s * (1.0f / DM) + EPS);
#pragma unroll
        for (int j = 0; j < 16; ++j) h[w][lane + 64 * j] = v[j] * rs * nw[lane + 64 * j];
    }
    __syncthreads();
    for (int c = tid; c < INW; c += 256) {
        float a0 = 0.f, a1 = 0.f, a2 = 0.f, a3 = 0.f;
        for (int k = 0; k < DM; ++k) { const float wv = w_in[(size_t)k * INW + c]; a0 += h[0][k] * wv; a1 += h[1][k] * wv; a2 += h[2][k] * wv; a3 += h[3][k] * wv; }
        pr[0][c] = a0; pr[1][c] = a1; pr[2][c] = a2; pr[3][c] = a3;
    }
    __syncthreads();
    for (int idx = tid; idx < 4 * INW; idx += 256) {
        const int r = idx / INW, c = idx % INW; const int t = t0 + r; const float v = pr[r][c];
        if (c < 1024) {
            const int cc = c & 511, i = cc & 63, f = i & 31; const float2 cs = rt_ret[(size_t)t * 32 + f];
            const float x1 = pr[r][c - i + f], x2 = pr[r][c - i + f + 32];
            const float o = (i < 32) ? x1 * cs.x - x2 * cs.y : x1 * cs.y + x2 * cs.x;
            if (c < 512) RQ[(size_t)t * 512 + cc] = f2bf(o); else RK[(size_t)t * 512 + cc] = f2bf(o * 0.125f);
        } else if (c < 1536) RV[(size_t)t * 512 + c - 1024] = f2bf(v);
        else if (c < 2048) RG[(size_t)t * 512 + c - 1536] = f2bf(v);
        else if (c < 2304) CQ[(size_t)t * 256 + c - 2048] = f2bf(v);
        else if (c < 2432) CKV[(size_t)t * 128 + c - 2304] = f2bf(v);
        else { const int i = c - 2432, f = i & 15; const float2 cs = rt_mla[(size_t)t * 16 + f];
            const float x1 = pr[r][2432 + f], x2 = pr[r][2432 + f + 16];
            const float o = (i < 16) ? x1 * cs.x - x2 * cs.y : x1 * cs.y + x2 * cs.x;
            KPE[(size_t)t * 32 + i] = f2bf(o); }
    }
    {
        const int t = t0 + w; float s = 0.f;
#pragma unroll
        for (int j = 0; j < 4; ++j) { const float v = pr[w][2048 + lane + 64 * j]; s += v * v; }
        s = wave_sum(s);
        float s2 = 0.f;
#pragma unroll
        for (int j = 0; j < 2; ++j) { const float v = pr[w][2304 + lane + 64 * j]; s2 += v * v; }
        s2 = wave_sum(s2);
        if (lane == 0) { SSQ[t * 4] = s; SSQ[t * 4 + 1] = 0.f; SSQ[t * 4 + 2] = 0.f; SSQ[t * 4 + 3] = 0.f; SSKV[t * 4] = s2; SSKV[t * 4 + 1] = 0.f; SSKV[t * 4 + 2] = 0.f; SSKV[t * 4 + 3] = 0.f; }
    }
}

__global__ void __launch_bounds__(256) nk2_mlaup(const bf16_t* __restrict__ CQ, const bf16_t* __restrict__ CKV, const float* __restrict__ SSQ, const float* __restrict__ SSKV,
        const float* __restrict__ qnw, const float* __restrict__ w_uq, const float* __restrict__ kvnw, const float* __restrict__ w_ukv,
        const float2* __restrict__ rt_mla, bf16_t* QB, bf16_t* KVB) {
    __shared__ float cq[4][256];
    __shared__ float ckv[4][128];
    __shared__ float q[4][768];
    const int t0 = blockIdx.x * 4, tid = threadIdx.x, w = tid >> 6, lane = tid & 63;
    {
        const int t = t0 + w;
        const float rsq = rsqrtf((SSQ[t * 4] + SSQ[t * 4 + 1] + SSQ[t * 4 + 2] + SSQ[t * 4 + 3]) * (1.0f / 256) + EPS);
        const float rskv = rsqrtf((SSKV[t * 4] + SSKV[t * 4 + 1] + SSKV[t * 4 + 2] + SSKV[t * 4 + 3]) * (1.0f / 128) + EPS);
#pragma unroll
        for (int j = 0; j < 4; ++j) cq[w][lane + 64 * j] = bf2f(CQ[(size_t)t * 256 + lane + 64 * j]) * rsq * qnw[lane + 64 * j];
#pragma unroll
        for (int j = 0; j < 2; ++j) ckv[w][lane + 64 * j] = bf2f(CKV[(size_t)t * 128 + lane + 64 * j]) * rskv * kvnw[lane + 64 * j];
    }
    __syncthreads();
    for (int c = tid; c < 768; c += 256) {
        float a0 = 0.f, a1 = 0.f, a2 = 0.f, a3 = 0.f;
        for (int k = 0; k < 256; ++k) { const float wv = w_uq[(size_t)k * 768 + c]; a0 += cq[0][k] * wv; a1 += cq[1][k] * wv; a2 += cq[2][k] * wv; a3 += cq[3][k] * wv; }
        q[0][c] = a0; q[1][c] = a1; q[2][c] = a2; q[3][c] = a3;
    }
    for (int c = tid; c < 1024; c += 256) {
        float a0 = 0.f, a1 = 0.f, a2 = 0.f, a3 = 0.f;
        for (int k = 0; k < 128; ++k) { const float wv = w_ukv[(size_t)k * 1024 + c]; a0 += ckv[0][k] * wv; a1 += ckv[1][k] * wv; a2 += ckv[2][k] * wv; a3 += ckv[3][k] * wv; }
        KVB[(size_t)(t0 + 0) * 1024 + c] = f2bf(a0); KVB[(size_t)(t0 + 1) * 1024 + c] = f2bf(a1); KVB[(size_t)(t0 + 2) * 1024 + c] = f2bf(a2); KVB[(size_t)(t0 + 3) * 1024 + c] = f2bf(a3);
    }
    __syncthreads();
    for (int idx = tid; idx < 4 * 768; idx += 256) {
        const int r = idx / 768, c = idx % 768, t = t0 + r; const int hd = c / 96, d = c % 96; float o;
        if (d < 64) o = q[r][c];
        else { const int i = d - 64, f = i & 15; const float2 cs = rt_mla[(size_t)t * 16 + f];
            const float x1 = q[r][hd * 96 + 64 + f], x2 = q[r][hd * 96 + 64 + f + 16];
            o = (i < 16) ? x1 * cs.x - x2 * cs.y : x1 * cs.y + x2 * cs.x; }
        QB[(size_t)t * 768 + c] = f2bf(o * QSCALE);
    }
}

__device__ __forceinline__ float ret_lg(int h) { return log1pf(-exp2f(-5.0f - (float)h)); }
__global__ void __launch_bounds__(256) nk3_states(const bf16_t* __restrict__ RK, const bf16_t* __restrict__ RV, float* __restrict__ NS) {
    __shared__ bf16_t ks[128][64];
    __shared__ bf16_t vs[128][64];
    const int u = blockIdx.x, n = u & 63, bh = u >> 6, h = bh & 7, b = bh >> 3, tid = threadIdx.x;
    const size_t tb = (size_t)b * SEQ + (size_t)n * 128;
    for (int i = tid; i < 128 * 64; i += 256) { const int j = i >> 6, d = i & 63; ks[j][d] = RK[(tb + j) * 512 + h * 64 + d]; vs[j][d] = RV[(tb + j) * 512 + h * 64 + d]; }
    __syncthreads();
    const float lg = ret_lg(h);
    float acc[16];
#pragma unroll
    for (int i = 0; i < 16; ++i) acc[i] = 0.f;
    for (int j = 0; j < 128; ++j) {
        const float z = expf(lg * (127.0f - (float)j));
#pragma unroll
        for (int i = 0; i < 16; ++i) { const int idx = tid + 256 * i, d = idx >> 6, e = idx & 63; acc[i] += bf2f(ks[j][d]) * z * bf2f(vs[j][e]); }
    }
#pragma unroll
    for (int i = 0; i < 16; ++i) NS[(size_t)u * 4096 + tid + 256 * i] = acc[i];
}
__global__ void __launch_bounds__(256) nk3_scan(float* __restrict__ NS) {
    const int g = blockIdx.x * 256 + threadIdx.x; const int bh = g >> 12, el = g & 4095, h = bh & 7;
    const float cd = expf(ret_lg(h) * 128.0f);
    float R = 0.f;
    for (int n = 0; n < 64; ++n) { float* p = NS + ((size_t)(bh * 64 + n)) * 4096 + el; const float s = *p; *p = R; R = cd * R + s; }
}
constexpr int NK3O_LDS = 3 * 16384 + 16384 + 64 * 129 * 4 + 64 * 65 * 4;
__global__ void __launch_bounds__(256) nk3_out(const bf16_t* __restrict__ RQ, const bf16_t* __restrict__ RK, const bf16_t* __restrict__ RV, const bf16_t* __restrict__ RG,
        const float* __restrict__ NS, const float* __restrict__ gnw, bf16_t* __restrict__ MIX) {
    extern __shared__ __attribute__((aligned(16))) unsigned char smem[];
    bf16_t (*qs)[64] = (bf16_t(*)[64])smem;
    bf16_t (*ks)[64] = (bf16_t(*)[64])(smem + 16384);
    bf16_t (*vs)[64] = (bf16_t(*)[64])(smem + 32768);
    float (*Rp)[64] = (float(*)[64])(smem + 49152);
    float (*sc)[129] = (float(*)[129])(smem + 65536);
    float (*ob)[65] = (float(*)[65])(smem + 65536 + 64 * 129 * 4);
    const int u = blockIdx.x, n = u & 63, bh = u >> 6, h = bh & 7, b = bh >> 3, tid = threadIdx.x, w = tid >> 6, lane = tid & 63;
    const size_t tb = (size_t)b * SEQ + (size_t)n * 128;
    for (int i = tid; i < 128 * 64; i += 256) { const int j = i >> 6, d = i & 63; const size_t o = (tb + j) * 512 + h * 64 + d; qs[j][d] = RQ[o]; ks[j][d] = RK[o]; vs[j][d] = RV[o]; }
    for (int i = tid; i < 4096; i += 256) Rp[i >> 6][i & 63] = NS[(size_t)u * 4096 + i];
    __syncthreads();
    const float lg = ret_lg(h);
    for (int half = 0; half < 2; ++half) {
        const int i0 = half * 64;
        for (int it = 0; it < 32; ++it) {
            const int idx = tid + 256 * it, i = idx >> 7, j = idx & 127, ig = i0 + i; float v = 0.f;
            if (j <= ig) { float a = 0.f;
                for (int d = 0; d < 64; ++d) a += bf2f(qs[ig][d]) * bf2f(ks[j][d]);
                v = a * expf(lg * (float)(ig - j)); }
            sc[i][j] = v;
        }
        __syncthreads();
        for (int it = 0; it < 16; ++it) {
            const int idx = tid + 256 * it, i = idx >> 6, e = idx & 63, ig = i0 + i; float a = 0.f;
            for (int j = 0; j <= ig; ++j) a += sc[i][j] * bf2f(vs[j][e]);
            float c = 0.f;
            for (int d = 0; d < 64; ++d) c += bf2f(qs[ig][d]) * Rp[d][e];
            ob[i][e] = a + c * expf(lg * (float)(ig + 1));
        }
        __syncthreads();
        for (int rr = 0; rr < 16; ++rr) {
            const int i = w * 16 + rr, ig = i0 + i; const size_t t = tb + ig;
            const float v = ob[i][lane]; const float mu = wave_sum(v) * (1.0f / 64); const float dv = v - mu; const float var = wave_sum(dv * dv) * (1.0f / 64);
            const float y = dv * rsqrtf(var + EPS) * gnw[h * 64 + lane];
            const float g = bf2f(RG[t * 512 + h * 64 + lane]);
            MIX[t * 1024 + h * 64 + lane] = f2bf(g / (1.0f + expf(-g)) * y);
        }
        __syncthreads();
    }
}

__global__ void __launch_bounds__(512) nk3_attn(const bf16_t* __restrict__ QB, const bf16_t* __restrict__ KVB, const bf16_t* __restrict__ KPE, bf16_t* __restrict__ MIX) {
    __shared__ __attribute__((aligned(16))) bf16_t kt[64][104];
    __shared__ __attribute__((aligned(16))) bf16_t vt[64][64];
    __shared__ float qv[8][96];
    __shared__ float ps[8][64];
    const int tid = threadIdx.x, w = tid >> 6, lane = tid & 63;
    const int bh = blockIdx.x >> 10, sblk = blockIdx.x & 1023, b = bh >> 3, h = bh & 7;
    const int s = sblk * 8 + w; const size_t t = (size_t)b * SEQ + s;
    for (int d = lane; d < 96; d += 64) qv[w][d] = bf2f(QB[t * 768 + h * 96 + d]);
    float m = -INFINITY, l = 0.f, o = 0.f;
    const int ntile = (sblk * 8 + 7) / 64 + 1;
    for (int kb = 0; kb < ntile; ++kb) {
        __syncthreads();
        {
            const int r = tid >> 3, c = tid & 7; const size_t tk = (size_t)b * SEQ + kb * 64 + r;
            *(uint4*)&kt[r][c * 8] = *(const uint4*)&KVB[tk * 1024 + h * 128 + c * 8];
            *(uint4*)&vt[r][c * 8] = *(const uint4*)&KVB[tk * 1024 + h * 128 + 64 + c * 8];
            if (tid < 256) { const int r2 = tid >> 2, c2 = tid & 3; const size_t tk2 = (size_t)b * SEQ + kb * 64 + r2; *(uint4*)&kt[r2][64 + c2 * 8] = *(const uint4*)&KPE[tk2 * 32 + c2 * 8]; }
        }
        __syncthreads();
        const int key = kb * 64 + lane; const bool valid = key <= s;
        float a = 0.f;
        for (int d = 0; d < 96; ++d) a += qv[w][d] * bf2f(kt[lane][d]);
        const float scv = valid ? a : -INFINITY;
        const float mn = fmaxf(m, wave_max(scv));
        const float p = valid ? exp2f(a - mn) : 0.f;
        const float alpha = exp2f(m - mn);
        l = l * alpha + wave_sum(p);
        ps[w][lane] = p;
        __builtin_amdgcn_s_waitcnt(0);
        float acc = 0.f;
        for (int j = 0; j < 64; ++j) acc += ps[w][j] * bf2f(vt[j][lane]);
        o = o * alpha + acc; m = mn;
    }
    MIX[t * 1024 + 512 + h * 64 + lane] = f2bf(o / l);
}

__device__ __forceinline__ size_t prow(int t) { const int b = t / SEQ, s = t % SEQ; return (size_t)b * SEQP + 2 + s; }
__global__ void __launch_bounds__(256) nk4_outproj(const float* __restrict__ x, const bf16_t* __restrict__ MIX, const float* __restrict__ w_out,
        float* __restrict__ X1, bf16_t* __restrict__ X1B, float* __restrict__ SS2) {
    __shared__ float mx[4][1024];
    __shared__ float red[4][4];
    const int t0 = blockIdx.x * 4, tid = threadIdx.x, w = tid >> 6, lane = tid & 63;
    for (int i = tid; i < 4096; i += 256) mx[i >> 10][i & 1023] = bf2f(MIX[(size_t)t0 * 1024 + i]);
    if ((t0 % SEQ) == 0) { const int b = t0 / SEQ; for (int i = tid; i < 2048; i += 256) X1B[(size_t)b * SEQP * 1024 + i] = 0; }
    __syncthreads();
    float ss[4] = {0.f, 0.f, 0.f, 0.f};
    for (int c = tid; c < 1024; c += 256) {
        float a0 = 0.f, a1 = 0.f, a2 = 0.f, a3 = 0.f;
        for (int k = 0; k < 1024; ++k) { const float wv = w_out[(size_t)k * 1024 + c]; a0 += mx[0][k] * wv; a1 += mx[1][k] * wv; a2 += mx[2][k] * wv; a3 += mx[3][k] * wv; }
        float v[4] = {a0, a1, a2, a3};
#pragma unroll
        for (int r = 0; r < 4; ++r) { const float x1 = x[(size_t)(t0 + r) * 1024 + c] + v[r]; X1[(size_t)(t0 + r) * 1024 + c] = x1; X1B[prow(t0 + r) * 1024 + c] = f2bf(x1); ss[r] += x1 * x1; }
    }
#pragma unroll
    for (int r = 0; r < 4; ++r) { const float s = wave_sum(ss[r]); if (lane == 0) red[r][w] = s; }
    __syncthreads();
    if (tid < 64) { const int r = tid >> 4, j = tid & 15; SS2[(size_t)(t0 + r) * 16 + j] = (j == 0) ? red[r][0] + red[r][1] + red[r][2] + red[r][3] : 0.f; }
}

__global__ void __launch_bounds__(256) nk5_up(const float* __restrict__ X1, const float* __restrict__ SS2, const float* __restrict__ fnw, const float* __restrict__ w_up,
        const float* __restrict__ conv_w, const float* __restrict__ conv_b, bf16_t* __restrict__ ACT) {
    __shared__ float h2[10][1024];
    const int t0 = blockIdx.x * 8, s0 = t0 % SEQ, tid = threadIdx.x, w = tid >> 6, lane = tid & 63;
    for (int r = w; r < 10; r += 4) {
        const int t = t0 - 2 + r; const bool ok = (s0 + r - 2) >= 0;
        float rs = 0.f;
        if (ok) { float s = 0.f; for (int j = 0; j < 16; ++j) s += SS2[(size_t)t * 16 + j]; rs = rsqrtf(s * (1.0f / 1024) + EPS); }
        for (int j = 0; j < 16; ++j) { const int c = lane + 64 * j; h2[r][c] = ok ? X1[(size_t)t * 1024 + c] * rs * fnw[c] : 0.f; }
    }
    __syncthreads();
    for (int f = tid; f < FF; f += 256) {
        float ag[10], av[10];
#pragma unroll
        for (int r = 0; r < 10; ++r) { ag[r] = 0.f; av[r] = 0.f; }
        for (int k = 0; k < 1024; ++k) {
            const float wg = w_up[(size_t)k * FF2 + f], wv = w_up[(size_t)k * FF2 + FF + f];
#pragma unroll
            for (int r = 0; r < 10; ++r) { const float hv = h2[r][k]; ag[r] += hv * wg; av[r] += hv * wv; }
        }
        const float g0 = conv_w[f], g1 = conv_w[FF2 + f], g2 = conv_w[2 * FF2 + f], gb = conv_b[f];
        const float v0 = conv_w[FF + f], v1 = conv_w[FF2 + FF + f], v2 = conv_w[2 * FF2 + FF + f], vb = conv_b[FF + f];
#pragma unroll
        for (int r = 2; r < 10; ++r) {
            const float cg = gb + g0 * ag[r - 2] + g1 * ag[r - 1] + g2 * ag[r];
            const float cv = vb + v0 * av[r - 2] + v1 * av[r - 1] + v2 * av[r];
            ACT[(size_t)(t0 + r - 2) * FF + f] = f2bf(cg / (1.0f + expf(-cg)) * cv);
        }
    }
}

__global__ void __launch_bounds__(256) nk6_down(const bf16_t* __restrict__ ACT, const float* __restrict__ w_down, float* __restrict__ X, float* __restrict__ SS3) {
    __shared__ float a[4][FF];
    __shared__ float red[4][4];
    const int t0 = blockIdx.x * 4, tid = threadIdx.x, w = tid >> 6, lane = tid & 63;
    for (int i = tid; i < 4 * FF; i += 256) a[i / FF][i % FF] = bf2f(ACT[(size_t)t0 * FF + i]);
    __syncthreads();
    float ss[4] = {0.f, 0.f, 0.f, 0.f};
    for (int c = tid; c < 1024; c += 256) {
        float a0 = 0.f, a1 = 0.f, a2 = 0.f, a3 = 0.f;
        for (int k = 0; k < FF; ++k) { const float wv = w_down[(size_t)k * 1024 + c]; a0 += a[0][k] * wv; a1 += a[1][k] * wv; a2 += a[2][k] * wv; a3 += a[3][k] * wv; }
        float v[4] = {a0, a1, a2, a3};
#pragma unroll
        for (int r = 0; r < 4; ++r) { const float x2 = X[(size_t)(t0 + r) * 1024 + c] + v[r]; X[(size_t)(t0 + r) * 1024 + c] = x2; ss[r] += x2 * x2; }
    }
#pragma unroll
    for (int r = 0; r < 4; ++r) { const float s = wave_sum(ss[r]); if (lane == 0) red[r][w] = s; }
    __syncthreads();
    if (tid < 64) { const int r = tid >> 4, j = tid & 15; SS3[(size_t)(t0 + r) * 16 + j] = (j == 0) ? red[r][0] + red[r][1] + red[r][2] + red[r][3] : 0.f; }
}

__global__ void __launch_bounds__(256) nk7_final(float* __restrict__ X, const float* __restrict__ SS3, const float* __restrict__ fw) {
    const int t = blockIdx.x * 4 + (threadIdx.x >> 6), lane = threadIdx.x & 63;
    float s = 0.f;
#pragma unroll
    for (int j = 0; j < 16; ++j) s += SS3[(size_t)t * 16 + j];
    const float rs = rsqrtf(s * (1.0f / 1024) + EPS);
    float4* xr = (float4*)(X + (size_t)t * 1024) + lane; const float4* wr = (const float4*)fw + lane;
#pragma unroll
    for (int j = 0; j < 4; ++j) { float4 v = xr[64 * j]; const float4 g = wr[64 * j]; v.x *= rs * g.x; v.y *= rs * g.y; v.z *= rs * g.z; v.w *= rs * g.w; xr[64 * j] = v; }
}

#define LAS __attribute__((address_space(3)))
#define GAS __attribute__((address_space(1)))
typedef short bf16x8 __attribute__((ext_vector_type(8)));
typedef float f32x4 __attribute__((ext_vector_type(4)));
typedef float f32x2 __attribute__((ext_vector_type(2)));
typedef unsigned u32x4 __attribute__((ext_vector_type(4)));
typedef unsigned u32x2 __attribute__((ext_vector_type(2)));
typedef __bf16 bf16x2_t __attribute__((ext_vector_type(2)));
__device__ __forceinline__ unsigned pk2(float lo, float hi) { f32x2 v = {lo, hi}; bf16x2_t b = __builtin_convertvector(v, bf16x2_t); return __builtin_bit_cast(unsigned, b); }

__device__ __forceinline__ int lane_id_v() { int l; asm volatile("v_mbcnt_lo_u32_b32 %0, -1, 0\n\tv_mbcnt_hi_u32_b32 %0, -1, %0" : "=v"(l)); return l; }

namespace pg8 {
constexpr int BM = 256, BK = 64, HALF = 128, HTB = HALF * BK * 2, STAGE_BYTES = 8 * HTB, NXCD = 8, WGM = 8;
__host__ __device__ __forceinline__ int lds_byte(int r, int c) { const int st = (r >> 4) * 2 + (c >> 5), rr = r & 15, cc = c & 31, ob = rr * 64 + cc * 2; return st * 1024 + (ob ^ (((ob >> 9) & 1) << 5)); }
__host__ __device__ __forceinline__ void stage_rc(int b, int& R, int& C) { const int st = b / 1024, sb = b % 1024, swz = sb ^ (((sb >> 9) & 1) << 5); R = (st >> 1) * 16 + swz / 64; C = (st & 1) * 32 + (swz % 64) / 2; }
__host__ __device__ __forceinline__ int perm32(int rho) { const int n = rho >> 4, i = rho & 15; return 8 * (i >> 2) + 4 * n + (i & 3); }
struct Unit { int pm, pn; };
struct Gemm { const bf16_t* A; const bf16_t* Bt; int nM, nN, K; int amode; };
__device__ __forceinline__ const char* a_tile(const Gemm& g, int pm) {
    if (g.amode == 0) return (const char*)g.A + (size_t)pm * 256 * g.K * 2;
    const int b = pm / 33, i = pm - b * 33; return (const char*)g.A + ((size_t)b * SEQP + (size_t)254 * i) * g.K * 2;
}
struct StaticOrder {
    int nM, nN, nwg, G, c;
    __device__ void init(int nM_, int nN_, int G_, int c_) { nM = nM_; nN = nN_; nwg = nM * nN; G = G_; c = c_; }
    __device__ bool next(int i, Unit& u) const {
        const long L = (long)i * G + c; if (L >= nwg) return false;
        int wgid = (int)L; { const int q = nwg / NXCD, r = nwg % NXCD, xcd = wgid % NXCD, off = wgid / NXCD; wgid = (xcd < r ? xcd * (q + 1) : r * (q + 1) + (xcd - r) * q) + off; }
        const int nig = WGM * nN, gid = wgid / nig, fm = gid * WGM, gsz = (nM - fm) < WGM ? (nM - fm) : WGM;
        u.pm = fm + ((wgid % nig) % gsz); u.pn = (wgid % nig) / gsz; return true;
    }
};

template <class Epi, bool ALIGN_EPI, bool SP2>
__device__ __forceinline__ void gemm_phase(LAS unsigned char* lds, const Gemm g, const StaticOrder& S, const Epi& E, int wave_s) {
    const int tid_ = (wave_s << 6) | lane_id_v();
    const int tid = tid_, wid = __builtin_amdgcn_readfirstlane(tid >> 6), lane = tid & 63, wr = wid >> 2, wc = wid & 3, fr = lane & 15, fq = lane >> 4;
    const int K = g.K, nt = K / BK;
    unsigned voffA[2], voffB[2];
#pragma unroll
    for (int i = 0; i < 2; ++i) { int R, C; stage_rc(tid * 16 + i * 8192, R, C); const int Rb = (R & ~31) + perm32(R & 31);
        voffA[i] = (unsigned)(R * K + C) * 2u; voffB[i] = (unsigned)(Rb * K + C) * 2u; }
    const size_t kstep = (size_t)(BK * 2);
    const size_t hstep = (size_t)HALF * K * 2;
    const size_t tstep = 2 * hstep;
    const unsigned ldsw = (unsigned)wid * 1024u;
    const int aoff = lds_byte(wr * 64 + fr, fq * 8), boff = lds_byte(wc * 32 + fr, fq * 8);
#define PG8_SA(b, h) (((b) * 2 + (h)) * HTB)
#define PG8_SB(b, h) ((4 + (b) * 2 + (h)) * HTB)
#define PG8_STAGE(bufoff, gbase, voff) do { _Pragma("unroll") for (int _i = 0; _i < 2; ++_i) \
        __builtin_amdgcn_global_load_lds((const unsigned*)((const char*)(gbase) + (voff)[_i]), (LAS unsigned*)(lds + (bufoff) + ldsw + _i * 8192), 16, 0, 0); } while (0)
#define PG8_LDA(dst, b, h) do { _Pragma("unroll") for (int m = 0; m < 4; ++m) _Pragma("unroll") for (int k = 0; k < 2; ++k) dst[m][k] = *(const LAS bf16x8*)(lds + PG8_SA(b, h) + aoff + m * 2048 + k * 1024); } while (0)
#define PG8_LDB(dst, b, h) do { _Pragma("unroll") for (int n = 0; n < 2; ++n) _Pragma("unroll") for (int k = 0; k < 2; ++k) dst[n][k] = *(const LAS bf16x8*)(lds + PG8_SB(b, h) + boff + n * 2048 + k * 1024); } while (0)
#define PG8_MMA(ai, bj, At, Bt) do { __builtin_amdgcn_s_setprio(1); _Pragma("unroll") for (int m = 0; m < 4; ++m) _Pragma("unroll") for (int n = 0; n < 2; ++n) _Pragma("unroll") for (int k = 0; k < 2; ++k) \
        acc[ai][bj][m][n] = __builtin_amdgcn_mfma_f32_16x16x32_bf16(Bt[n][k], At[m][k], acc[ai][bj][m][n], 0, 0, 0); __builtin_amdgcn_s_setprio(0); } while (0)
#define PG8_WAIT_V(n) asm volatile("s_waitcnt vmcnt(" #n ")" ::: "memory")
#define PG8_WAIT_L(n) asm volatile("s_waitcnt lgkmcnt(" #n ")" ::: "memory")
#define PG8_BAR __builtin_amdgcn_s_barrier()
#define PG8_SCHED __builtin_amdgcn_sched_barrier(0)
    Unit cur, nxt; int ui = 0;
    if (!S.next(0, cur)) return;
    f32x4 acc[2][2][4][2];
#pragma unroll
    for (int a = 0; a < 2; ++a)
#pragma unroll
        for (int b = 0; b < 2; ++b)
#pragma unroll
            for (int m = 0; m < 4; ++m)
#pragma unroll
                for (int n = 0; n < 2; ++n) acc[a][b][m][n] = (f32x4){0.f, 0.f, 0.f, 0.f};
    bf16x8 At[4][2], B0[2][2], B1[2][2];
    const char* cA = a_tile(g, cur.pm); const char* cB = (const char*)g.Bt + (size_t)cur.pn * tstep;
    if constexpr (SP2) {
        PG8_STAGE(PG8_SB(0, 0), cB, voffB); PG8_STAGE(PG8_SB(0, 1), cB + hstep, voffB); PG8_STAGE(PG8_SA(0, 0), cA, voffA); PG8_STAGE(PG8_SA(0, 1), cA + hstep, voffA);
        if (wr == 1) PG8_BAR;
        PG8_WAIT_V(2); PG8_BAR;
        PG8_STAGE(PG8_SB(1, 0), cB + kstep, voffB); PG8_STAGE(PG8_SA(1, 0), cA + kstep, voffA); PG8_STAGE(PG8_SB(1, 1), cB + hstep + kstep, voffB);
        PG8_WAIT_V(6); PG8_BAR;
    } else {
        PG8_STAGE(PG8_SB(0, 0), cB, voffB); PG8_STAGE(PG8_SA(0, 0), cA, voffA); PG8_STAGE(PG8_SB(0, 1), cB + hstep, voffB); PG8_STAGE(PG8_SA(0, 1), cA + hstep, voffA);
        if (wr == 1) PG8_BAR;
        PG8_WAIT_V(4); PG8_BAR;
        PG8_STAGE(PG8_SB(1, 0), cB + kstep, voffB); PG8_STAGE(PG8_SA(1, 0), cA + kstep, voffA); PG8_STAGE(PG8_SB(1, 1), cB + hstep + kstep, voffB);
        PG8_WAIT_V(6); PG8_BAR;
    }
    for (;;) {
        const bool has_next = S.next(ui + 1, nxt);
        const char* nA = has_next ? a_tile(g, nxt.pm) : cA; const char* nB = has_next ? (const char*)g.Bt + (size_t)nxt.pn * tstep : cB;
        for (int t = 0; t < nt; t += 2) {
            const bool last = (t == nt - 2);
            const char* a1 = cA + (size_t)(t + 1) * kstep;
            const char* a2 = last ? nA : cA + (size_t)(t + 2) * kstep; const char* b2 = last ? nB : cB + (size_t)(t + 2) * kstep;
            const char* a3 = a2 + kstep; const char* b3 = b2 + kstep;
            if constexpr (SP2) {
            PG8_LDB(B0, 0, 0); PG8_LDB(B1, 0, 1); PG8_SCHED; PG8_LDA(At, 0, 0); PG8_STAGE(PG8_SA(1, 1), a1 + hstep, voffA);
            PG8_WAIT_V(8); PG8_WAIT_L(0); PG8_BAR; PG8_MMA(0, 0, At, B0); PG8_MMA(0, 1, At, B1); PG8_BAR; PG8_SCHED;
            PG8_LDA(At, 0, 1); PG8_STAGE(PG8_SB(0, 0), b2, voffB); PG8_STAGE(PG8_SB(0, 1), b2 + hstep, voffB); PG8_STAGE(PG8_SA(0, 0), a2, voffA);
            PG8_WAIT_V(8); PG8_WAIT_L(0); PG8_BAR; PG8_MMA(1, 0, At, B0); PG8_MMA(1, 1, At, B1); PG8_BAR; PG8_SCHED;
            PG8_LDB(B0, 1, 0); PG8_LDB(B1, 1, 1); PG8_SCHED; PG8_LDA(At, 1, 0); PG8_STAGE(PG8_SA(0, 1), a2 + hstep, voffA);
            PG8_WAIT_V(8); PG8_WAIT_L(0); PG8_BAR; PG8_MMA(0, 0, At, B0); PG8_MMA(0, 1, At, B1); PG8_BAR; PG8_SCHED;
            PG8_LDA(At, 1, 1); PG8_STAGE(PG8_SB(1, 0), b3, voffB); PG8_STAGE(PG8_SB(1, 1), b3 + hstep, voffB); PG8_STAGE(PG8_SA(1, 0), a3, voffA);
            PG8_WAIT_V(8); PG8_WAIT_L(0); PG8_BAR; PG8_MMA(1, 0, At, B0); PG8_MMA(1, 1, At, B1); PG8_BAR; PG8_SCHED;
            } else {
            PG8_LDB(B0, 0, 0); PG8_SCHED; PG8_LDA(At, 0, 0); PG8_STAGE(PG8_SA(1, 1), a1 + hstep, voffA);
            PG8_WAIT_L(8); PG8_BAR; PG8_WAIT_L(0); PG8_MMA(0, 0, At, B0); PG8_BAR; PG8_SCHED;
            PG8_LDB(B1, 0, 1); PG8_STAGE(PG8_SB(0, 0), b2, voffB);
            PG8_BAR; PG8_WAIT_L(0); PG8_MMA(0, 1, At, B1); PG8_BAR;
            PG8_LDA(At, 0, 1); PG8_STAGE(PG8_SA(0, 0), a2, voffA);
            PG8_BAR; PG8_WAIT_L(0); PG8_MMA(1, 0, At, B0); PG8_BAR; PG8_SCHED;
            PG8_STAGE(PG8_SB(0, 1), b2 + hstep, voffB);
            PG8_WAIT_V(6); PG8_BAR; PG8_MMA(1, 1, At, B1); PG8_BAR;
            PG8_LDB(B0, 1, 0); PG8_SCHED; PG8_LDA(At, 1, 0); PG8_STAGE(PG8_SA(0, 1), a2 + hstep, voffA);
            PG8_WAIT_L(8); PG8_BAR; PG8_WAIT_L(0); PG8_MMA(0, 0, At, B0); PG8_BAR; PG8_SCHED;
            PG8_LDB(B1, 1, 1); PG8_STAGE(PG8_SB(1, 0), b3, voffB);
            PG8_BAR; PG8_WAIT_L(0); PG8_MMA(0, 1, At, B1); PG8_BAR;
            PG8_LDA(At, 1, 1); PG8_STAGE(PG8_SA(1, 0), a3, voffA);
            PG8_BAR; PG8_WAIT_L(0); PG8_MMA(1, 0, At, B0); PG8_BAR; PG8_SCHED;
            PG8_STAGE(PG8_SB(1, 1), b3 + hstep, voffB);
            PG8_WAIT_V(6); PG8_BAR; PG8_MMA(1, 1, At, B1); PG8_BAR;
            }
        }
        if constexpr (ALIGN_EPI) { if (wr == 0) PG8_BAR; }
        E(acc, cur, wr, wc, fr, fq);
        if (!has_next) break;
#pragma unroll
        for (int a = 0; a < 2; ++a)
#pragma unroll
            for (int b = 0; b < 2; ++b)
#pragma unroll
                for (int m = 0; m < 4; ++m)
#pragma unroll
                    for (int n = 0; n < 2; ++n) acc[a][b][m][n] = (f32x4){0.f, 0.f, 0.f, 0.f};
        cur = nxt; cA = nA; cB = nB; ++ui;
        if constexpr (ALIGN_EPI) { if (wr == 1) PG8_BAR; }
    }
    PG8_WAIT_V(0);
    if constexpr (!ALIGN_EPI) { if (wr == 0) PG8_BAR; }
    PG8_BAR;
#undef PG8_SA
#undef PG8_SB
#undef PG8_STAGE
#undef PG8_LDA
#undef PG8_LDB
#undef PG8_MMA
#undef PG8_WAIT_V
#undef PG8_WAIT_L
#undef PG8_BAR
#undef PG8_SCHED
}

typedef f32x4 Acc[2][2][4][2];
__device__ __forceinline__ float quad_sum(float s) { s += __shfl_xor(s, 16); s += __shfl_xor(s, 32); return s; }
__device__ __forceinline__ u32x4 pack8(f32x4 a, f32x4 b) { u32x4 w; w.x = pk2(a[0], a[1]); w.y = pk2(a[2], a[3]); w.z = pk2(b[0], b[1]); w.w = pk2(b[2], b[3]); return w; }

struct EpiInProj {
    unsigned char* ws;
    __device__ __forceinline__ void operator()(Acc& acc, const Unit& u, int wr, int wc, int fr, int fq) const {
        const int pn = u.pn; const int row0 = u.pm * 256 + wr * 64 + fr;
        bf16_t *RQ = (bf16_t*)(ws + WS_RQ), *RK = (bf16_t*)(ws + WS_RK), *RV = (bf16_t*)(ws + WS_RV), *RG = (bf16_t*)(ws + WS_RG), *CQ = (bf16_t*)(ws + WS_CQ), *CKV = (bf16_t*)(ws + WS_CKV), *KPE = (bf16_t*)(ws + WS_KPE);
        const float* rs1 = (const float*)(ws + WS_RS1); float *SSQ = (float*)(ws + WS_SSQ), *SSKV = (float*)(ws + WS_SSKV); const float2 *rt_ret = (const float2*)(ws + WS_RTRET), *rt_mla = (const float2*)(ws + WS_RTMLA);
        if (pn < 4) {
            bf16_t* dst = pn < 2 ? RQ : RK; const float ks = pn < 2 ? 1.f : 0.125f; const int hc = (4 * (pn & 1) + wc) * 64 + 8 * fq;
#pragma unroll
            for (int ai = 0; ai < 2; ++ai)
#pragma unroll
                for (int m = 0; m < 4; ++m) {
                    const int t = row0 + ai * 128 + m * 16; const float rs = rs1[t] * ks;
                    const f32x4* tp = (const f32x4*)(rt_ret + (size_t)t * 32 + 8 * fq);
                    f32x4 o1[2], o2[2];
#pragma unroll
                    for (int n = 0; n < 2; ++n) { const f32x4 cA = tp[2 * n], cB = tp[2 * n + 1]; const f32x4 x1 = acc[ai][0][m][n] * rs, x2 = acc[ai][1][m][n] * rs;
                        o1[n][0] = x1[0] * cA[0] - x2[0] * cA[1]; o2[n][0] = x1[0] * cA[1] + x2[0] * cA[0];
                        o1[n][1] = x1[1] * cA[2] - x2[1] * cA[3]; o2[n][1] = x1[1] * cA[3] + x2[1] * cA[2];
                        o1[n][2] = x1[2] * cB[0] - x2[2] * cB[1]; o2[n][2] = x1[2] * cB[1] + x2[2] * cB[0];
                        o1[n][3] = x1[3] * cB[2] - x2[3] * cB[3]; o2[n][3] = x1[3] * cB[3] + x2[3] * cB[2]; }
                    *(u32x4*)(dst + (size_t)t * 512 + hc) = pack8(o1[0], o1[1]);
                    *(u32x4*)(dst + (size_t)t * 512 + hc + 32) = pack8(o2[0], o2[1]);
                }
        } else if (pn < 8) {
            bf16_t* dst = pn < 6 ? RV : RG; const int cb = (pn & 1) * 256 + wc * 32 + 8 * fq;
#pragma unroll
            for (int ai = 0; ai < 2; ++ai)
#pragma unroll
                for (int m = 0; m < 4; ++m) { const int t = row0 + ai * 128 + m * 16; const float rs = rs1[t];
#pragma unroll
                    for (int bj = 0; bj < 2; ++bj) *(u32x4*)(dst + (size_t)t * 512 + cb + bj * 128) = pack8(acc[ai][bj][m][0] * rs, acc[ai][bj][m][1] * rs); }
        } else if (pn == 8) {
#pragma unroll
            for (int ai = 0; ai < 2; ++ai)
#pragma unroll
                for (int m = 0; m < 4; ++m) { const int t = row0 + ai * 128 + m * 16; const float rs = rs1[t]; float ss = 0.f;
#pragma unroll
                    for (int bj = 0; bj < 2; ++bj) { const f32x4 a = acc[ai][bj][m][0] * rs, b = acc[ai][bj][m][1] * rs;
                        ss += (a[0] * a[0] + a[1] * a[1]) + (a[2] * a[2] + a[3] * a[3]) + (b[0] * b[0] + b[1] * b[1]) + (b[2] * b[2] + b[3] * b[3]);
                        *(u32x4*)(CQ + (size_t)t * 256 + bj * 128 + wc * 32 + 8 * fq) = pack8(a, b); }
                    ss = quad_sum(ss); if (fq == 0) SSQ[(size_t)t * 4 + wc] = ss; }
        } else {
#pragma unroll
            for (int ai = 0; ai < 2; ++ai)
#pragma unroll
                for (int m = 0; m < 4; ++m) { const int t = row0 + ai * 128 + m * 16; const float rs = rs1[t];
                    const f32x4 a = acc[ai][0][m][0] * rs, b = acc[ai][0][m][1] * rs;
                    float ss = (a[0] * a[0] + a[1] * a[1]) + (a[2] * a[2] + a[3] * a[3]) + (b[0] * b[0] + b[1] * b[1]) + (b[2] * b[2] + b[3] * b[3]);
                    *(u32x4*)(CKV + (size_t)t * 128 + wc * 32 + 8 * fq) = pack8(a, b);
                    ss = quad_sum(ss); if (fq == 0) SSKV[(size_t)t * 4 + wc] = ss;
                    if (wc == 0) { const f32x4* tp = (const f32x4*)(rt_mla + (size_t)t * 16 + 4 * fq); const f32x4 cA = tp[0], cB = tp[1];
                        const f32x4 x1 = acc[ai][1][m][0] * rs, x2 = acc[ai][1][m][1] * rs; f32x4 o1, o2;
                        o1[0] = x1[0] * cA[0] - x2[0] * cA[1]; o2[0] = x1[0] * cA[1] + x2[0] * cA[0];
                        o1[1] = x1[1] * cA[2] - x2[1] * cA[3]; o2[1] = x1[1] * cA[3] + x2[1] * cA[2];
                        o1[2] = x1[2] * cB[0] - x2[2] * cB[1]; o2[2] = x1[2] * cB[1] + x2[2] * cB[0];
                        o1[3] = x1[3] * cB[2] - x2[3] * cB[3]; o2[3] = x1[3] * cB[3] + x2[3] * cB[2];
                        u32x2 w1, w2; w1.x = pk2(o1[0], o1[1]); w1.y = pk2(o1[2], o1[3]); w2.x = pk2(o2[0], o2[1]); w2.y = pk2(o2[2], o2[3]);
                        *(u32x2*)(KPE + (size_t)t * 32 + 4 * fq) = w1; *(u32x2*)(KPE + (size_t)t * 32 + 16 + 4 * fq) = w2; }
                }
        }
    }
};

struct EpiQUp {
    unsigned char* ws;
    __device__ __forceinline__ void operator()(Acc& acc, const Unit& u, int wr, int wc, int fr, int fq) const {
        const int pn = u.pn; const int row0 = u.pm * 256 + wr * 64 + fr;
        bf16_t* QB = (bf16_t*)(ws + WS_QB); const float* SSQ = (const float*)(ws + WS_SSQ); const float2* rt_mla = (const float2*)(ws + WS_RTMLA);
        if (pn < 2) {
#pragma unroll
            for (int ai = 0; ai < 2; ++ai)
#pragma unroll
                for (int m = 0; m < 4; ++m) { const int t = row0 + ai * 128 + m * 16;
                    const f32x4 p = *(const f32x4*)(SSQ + (size_t)t * 4); const float rs = rsqrtf(((p[0] + p[1]) + (p[2] + p[3])) * (1.0f / 256) + EPS) * QSCALE;
#pragma unroll
                    for (int bj = 0; bj < 2; ++bj) { const int c = pn * 256 + bj * 128 + wc * 32 + 8 * fq; const int hd = c >> 6, d = c & 63;
                        *(u32x4*)(QB + (size_t)t * 768 + hd * 96 + d) = pack8(acc[ai][bj][m][0] * rs, acc[ai][bj][m][1] * rs); }
                    if (m & 1) asm volatile("" ::: "memory"); }
        } else {
#pragma unroll
            for (int ai = 0; ai < 2; ++ai)
#pragma unroll
                for (int m = 0; m < 4; ++m) { const int t = row0 + ai * 128 + m * 16;
                    const f32x4 p = *(const f32x4*)(SSQ + (size_t)t * 4); const float rs = rsqrtf(((p[0] + p[1]) + (p[2] + p[3])) * (1.0f / 256) + EPS) * QSCALE;
                    const f32x4* tp = (const f32x4*)(rt_mla + (size_t)t * 16 + 4 * fq); const f32x4 cA = tp[0], cB = tp[1];
#pragma unroll
                    for (int bj = 0; bj < 2; ++bj) { const int hd = 4 * bj + wc; const f32x4 x1 = acc[ai][bj][m][0] * rs, x2 = acc[ai][bj][m][1] * rs; f32x4 o1, o2;
                        o1[0] = x1[0] * cA[0] - x2[0] * cA[1]; o2[0] = x1[0] * cA[1] + x2[0] * cA[0];
                        o1[1] = x1[1] * cA[2] - x2[1] * cA[3]; o2[1] = x1[1] * cA[3] + x2[1] * cA[2];
                        o1[2] = x1[2] * cB[0] - x2[2] * cB[1]; o2[2] = x1[2] * cB[1] + x2[2] * cB[0];
                        o1[3] = x1[3] * cB[2] - x2[3] * cB[3]; o2[3] = x1[3] * cB[3] + x2[3] * cB[2];
                        u32x2 w1, w2; w1.x = pk2(o1[0], o1[1]); w1.y = pk2(o1[2], o1[3]); w2.x = pk2(o2[0], o2[1]); w2.y = pk2(o2[2], o2[3]);
                        *(u32x2*)(QB + (size_t)t * 768 + hd * 96 + 64 + 4 * fq) = w1; *(u32x2*)(QB + (size_t)t * 768 + hd * 96 + 80 + 4 * fq) = w2; }
                    asm volatile("" ::: "memory"); }
        }
    }
};
struct EpiKVUp {
    unsigned char* ws;
    __device__ __forceinline__ void operator()(Acc& acc, const Unit& u, int wr, int wc, int fr, int fq) const {
        bf16_t* KVB = (bf16_t*)(ws + WS_KVB); const float* SSKV = (const float*)(ws + WS_SSKV);
        const int row0 = u.pm * 256 + wr * 64 + fr, c0 = u.pn * 256 + wc * 32 + 8 * fq;
#pragma unroll
        for (int ai = 0; ai < 2; ++ai)
#pragma unroll
            for (int m = 0; m < 4; ++m) { const int t = row0 + ai * 128 + m * 16;
                const f32x4 p = *(const f32x4*)(SSKV + (size_t)t * 4); const float rs = rsqrtf(((p[0] + p[1]) + (p[2] + p[3])) * (1.0f / 128) + EPS);
#pragma unroll
                for (int bj = 0; bj < 2; ++bj) *(u32x4*)(KVB + (size_t)t * 1024 + c0 + bj * 128) = pack8(acc[ai][bj][m][0] * rs, acc[ai][bj][m][1] * rs); }
    }
};
template <bool WRITE_BF> struct EpiResid {
    const float* base; float* out; unsigned char* ws;
    __device__ __forceinline__ void operator()(Acc& acc, const Unit& u, int wr, int wc, int fr, int fq) const {
        bf16_t* X1B = (bf16_t*)(ws + WS_X1B); float* SS = (float*)(ws + (WRITE_BF ? WS_SS2 : WS_SS3));
        const int row0 = u.pm * 256 + wr * 64 + fr, c0 = u.pn * 256 + wc * 32 + 8 * fq;
#pragma unroll
        for (int ai = 0; ai < 2; ++ai)
#pragma unroll
            for (int m = 0; m < 4; ++m) { const int t = row0 + ai * 128 + m * 16; float ss = 0.f;
#pragma unroll
                for (int bj = 0; bj < 2; ++bj) { const size_t off = (size_t)t * 1024 + c0 + bj * 128;
                    const f32x4 a = *(const f32x4*)(base + off) + acc[ai][bj][m][0], b = *(const f32x4*)(base + off + 4) + acc[ai][bj][m][1];
                    *(f32x4*)(out + off) = a; *(f32x4*)(out + off + 4) = b;
                    ss += (a[0] * a[0] + a[1] * a[1]) + (a[2] * a[2] + a[3] * a[3]) + (b[0] * b[0] + b[1] * b[1]) + (b[2] * b[2] + b[3] * b[3]);
                    if (WRITE_BF) { const size_t pr = (size_t)(t >> 13) * SEQP + 2 + (t & 8191); *(u32x4*)(X1B + pr * 1024 + c0 + bj * 128) = pack8(a, b); } }
                ss = quad_sum(ss); if (fq == 0) SS[(size_t)t * 16 + u.pn * 4 + wc] = ss; }
    }
};
template <int CTRL> __device__ __forceinline__ float dppf(float old, float src) { return __builtin_bit_cast(float, __builtin_amdgcn_update_dpp(__builtin_bit_cast(int, old), __builtin_bit_cast(int, src), CTRL, 0xf, 0xf, false)); }
struct EpiUpConv {
    unsigned char* ws; const float* conv_w; const float* conv_b; LAS unsigned char* xch;
    __device__ __forceinline__ void operator()(Acc& acc, const Unit& u, int wr, int wc, int fr, int fq) const {
        const float* SS2 = (const float*)(ws + WS_SS2); bf16_t* ACT = (bf16_t*)(ws + WS_ACT);
        const int b = u.pm / 33, ti = u.pm - b * 33, sb = 254 * ti - 2;
#pragma unroll
        for (int ai = 0; ai < 2; ++ai)
#pragma unroll
            for (int m = 0; m < 4; ++m) { const int s = sb + ai * 128 + wr * 64 + m * 16 + fr; const bool ok = (s >= 0) && (s < SEQ);
                f32x4 p = {0.f, 0.f, 0.f, 0.f}; if (ok) p = *(const f32x4*)(SS2 + ((size_t)b * SEQ + s) * 16 + 4 * fq);
                const float sum = quad_sum((p[0] + p[1]) + (p[2] + p[3])); const float rs = ok ? rsqrtf(sum * (1.0f / 1024) + EPS) : 0.f;
#pragma unroll
                for (int bj = 0; bj < 2; ++bj)
#pragma unroll
                    for (int n = 0; n < 2; ++n) acc[ai][bj][m][n] = ok ? acc[ai][bj][m][n] * rs : (f32x4){0.f, 0.f, 0.f, 0.f}; }
        if (fr >= 14) {
#pragma unroll
            for (int ai = 0; ai < 2; ++ai)
#pragma unroll
                for (int bj = 0; bj < 2; ++bj)
#pragma unroll
                    for (int n = 0; n < 2; ++n) *(LAS f32x4*)(xch + ((((2 * ai + wr) * 2 + (fr - 14)) * 256) + bj * 128 + wc * 32 + 8 * fq + 4 * n) * 4) = acc[ai][bj][3][n];
        }
        asm volatile("s_waitcnt lgkmcnt(0)" ::: "memory"); __builtin_amdgcn_s_barrier(); asm volatile("" ::: "memory");
        const int f0 = u.pn * 128 + wc * 32 + 8 * fq;
#pragma unroll
        for (int n = 0; n < 2; ++n) {
            const int f = f0 + 4 * n;
            const f32x4 g0 = *(const f32x4*)(conv_w + f), g1 = *(const f32x4*)(conv_w + FF2 + f), g2 = *(const f32x4*)(conv_w + 2 * FF2 + f), gb = *(const f32x4*)(conv_b + f);
            const f32x4 v0 = *(const f32x4*)(conv_w + FF + f), v1 = *(const f32x4*)(conv_w + FF2 + FF + f), v2 = *(const f32x4*)(conv_w + 2 * FF2 + FF + f), vb = *(const f32x4*)(conv_b + FF + f);
#pragma unroll
            for (int ai = 0; ai < 2; ++ai) {
                const int blk = 2 * ai + wr;
                f32x4 pg = {0.f, 0.f, 0.f, 0.f}, pv = {0.f, 0.f, 0.f, 0.f};
                if (blk >= 1 && fr >= 14) { const LAS unsigned char* xp = xch + ((((blk - 1) * 2 + (fr - 14)) * 256) + wc * 32 + 8 * fq + 4 * n) * 4;
                    pg = *(const LAS f32x4*)xp; pv = *(const LAS f32x4*)(xp + 128 * 4); }
#pragma unroll
                for (int m = 0; m < 4; ++m) {
                    const f32x4 cg = acc[ai][0][m][n], cv = acc[ai][1][m][n];
                    f32x4 og, ov;
#pragma unroll
                    for (int e = 0; e < 4; ++e) {
                        const float g_1 = dppf<0x111>(dppf<0x121>(0.f, pg[e]), cg[e]), g_2 = dppf<0x112>(dppf<0x122>(0.f, pg[e]), cg[e]);
                        const float v_1 = dppf<0x111>(dppf<0x121>(0.f, pv[e]), cv[e]), v_2 = dppf<0x112>(dppf<0x122>(0.f, pv[e]), cv[e]);
                        og[e] = gb[e] + g0[e] * g_2 + g1[e] * g_1 + g2[e] * cg[e];
                        ov[e] = vb[e] + v0[e] * v_2 + v1[e] * v_1 + v2[e] * cv[e];
                    }
                    const int r = ai * 128 + wr * 64 + m * 16 + fr, s = sb + r;
                    if (r >= 2 && s < SEQ) {
                        f32x4 a;
#pragma unroll
                        for (int e = 0; e < 4; ++e) a[e] = og[e] * __builtin_amdgcn_rcpf(1.0f + __builtin_amdgcn_exp2f(-1.4426950408889634f * og[e])) * ov[e];
                        u32x2 w; w.x = pk2(a[0], a[1]); w.y = pk2(a[2], a[3]);
                        *(u32x2*)(ACT + ((size_t)b * SEQ + s) * FF + f) = w;
                    }
                    pg = cg; pv = cv;
                }
            }
        }
    }
};
}

namespace att {
typedef float f32x16 __attribute__((ext_vector_type(16)));
typedef short s16x4 __attribute__((ext_vector_type(4)));
typedef short v4i16_t __attribute__((ext_vector_type(4)));
constexpr int KSLOT = 12288, VSLOT = 8192, NSLOT = 3;
constexpr int L_K = 0, L_V = NSLOT * KSLOT, L_WS = L_V + NSLOT * VSLOT, L_OST = L_WS + 8 * 256, L_END = L_OST + 8 * 4096;
constexpr float THR = 8.0f;
__device__ __forceinline__ int crow(int r, int hi) { return (r & 3) + 8 * (r >> 2) + 4 * hi; }
#define ATT_WAIT_V(n) asm volatile("s_waitcnt vmcnt(" #n ")" ::: "memory")
#define ATT_BAR() do { asm volatile("s_waitcnt lgkmcnt(0)" ::: "memory"); __builtin_amdgcn_s_barrier(); asm volatile("" ::: "memory"); } while (0)
__device__ __forceinline__ void attn_unit(int b, int h, int qb, const bf16_t* __restrict__ QB, const bf16_t* __restrict__ KVB, const bf16_t* __restrict__ KPE, bf16_t* __restrict__ MIX, LAS unsigned char* lds, int wave_s) {
    const int tid_ = (wave_s << 6) | lane_id_v();
    const int lane = tid_ & 63, r32 = lane & 31, hi = lane >> 5, wid = wave_s;
    const size_t tb = (size_t)b * SEQ; const int q0 = qb * 256;
    const int NTILE = (q0 + 256) / 64;
    const bf16_t* ksrc = KVB + (tb + lane) * 1024 + h * 128 + wid * 8;
    const bf16_t* k2src = KPE + (tb + lane) * 32 + (wid & 3) * 8;
    const bf16_t* vsrc = KVB + (tb + 16 * (wid & 3) + (lane >> 2)) * 1024 + h * 128 + 64 + (wid >> 2) * 32 + (lane & 3) * 8;
#define ATT_DMA(t, slot) do { \
        __builtin_amdgcn_global_load_lds((const unsigned*)(ksrc + (size_t)(t) * 64 * 1024), (LAS unsigned*)(lds + L_K + (slot) * KSLOT + wid * 1024), 16, 0, 0); \
        if (wid < 4) __builtin_amdgcn_global_load_lds((const unsigned*)(k2src + (size_t)(t) * 64 * 32), (LAS unsigned*)(lds + L_K + (slot) * KSLOT + (8 + wid) * 1024), 16, 0, 0); \
        __builtin_amdgcn_global_load_lds((const unsigned*)(vsrc + (size_t)(t) * 64 * 1024), (LAS unsigned*)(lds + L_V + (slot) * VSLOT + wid * 1024), 16, 0, 0); } while (0)
    bf16x8 qr[6];
    { const bf16_t* qp = QB + (tb + q0 + wid * 32 + r32) * 768 + h * 96 + hi * 8;
#pragma unroll
      for (int d0 = 0; d0 < 6; ++d0) qr[d0] = *(const bf16x8*)(qp + d0 * 16); }
    ATT_DMA(0, 0); ATT_DMA(1, 1);
    LAS float* wsf = (LAS float*)(lds + L_WS) + wid * 64;
    const int kb0 = L_K + hi * 1024 + r32 * 16;
    const int vb0 = L_V + ((lane >> 4) & 1) * 32 + (lane & 3) * 8 + (4 * hi + ((lane & 15) >> 2)) * 64;
    float mref = 0.f, l = 0.f; f32x16 o0, o1, negm;
#pragma unroll
    for (int r = 0; r < 16; ++r) { o0[r] = 0.f; o1[r] = 0.f; negm[r] = 0.f; }
    const int qrel = wid * 32 + r32;
    int slot = 0;
    for (int t = 0; t < NTILE; ++t) {
        if (t + 1 < NTILE) { if (wid < 4) ATT_WAIT_V(3); else ATT_WAIT_V(2); } else ATT_WAIT_V(0);
        ATT_BAR();
        if (t + 2 < NTILE) { const int s2 = (slot == 0) ? 2 : slot - 1; ATT_DMA(t + 2, s2); }
        const int jb = t - (NTILE - 4);
        if (jb < 0 || 64 * jb <= 32 * wid + 31) {
            f32x16 p0 = negm, p1 = negm;
            const LAS unsigned char* kp = lds + kb0 + slot * KSLOT;
#pragma unroll
            for (int d0 = 0; d0 < 6; ++d0) {
                const bf16x8 ka = *(const LAS bf16x8*)(kp + d0 * 2048), kb = *(const LAS bf16x8*)(kp + d0 * 2048 + 512);
                p0 = __builtin_amdgcn_mfma_f32_32x32x16_bf16(ka, qr[d0], p0, 0, 0, 0);
                p1 = __builtin_amdgcn_mfma_f32_32x32x16_bf16(kb, qr[d0], p1, 0, 0, 0);
            }
            if (jb >= 0) {
#pragma unroll
                for (int r = 0; r < 16; ++r) { const int kv = 64 * jb + crow(r, hi); if (kv > qrel) p0[r] = -INFINITY; if (kv + 32 > qrel) p1[r] = -INFINITY; }
            }
            float rm = fmaxf(p0[0], p1[0]);
#pragma unroll
            for (int r = 1; r < 16; ++r) rm = fmaxf(rm, fmaxf(p0[r], p1[r]));
            rm = fmaxf(rm, __shfl_xor(rm, 32));
            const bool first = (t == 0);
            if (first || __any(rm > THR)) {
                const float dl = first ? rm : fmaxf(rm, 0.f);
                mref += dl;
#pragma unroll
                for (int r = 0; r < 16; ++r) { p0[r] -= dl; p1[r] -= dl; negm[r] = -mref; }
                const float f = __builtin_amdgcn_exp2f(-dl);
                l *= f;
                if (hi == 0) wsf[r32] = f;
                asm volatile("s_waitcnt lgkmcnt(0)" ::: "memory");
#pragma unroll
                for (int g = 0; g < 4; ++g) { const f32x4 fv = *(const LAS f32x4*)(wsf + 8 * g + 4 * hi);
#pragma unroll
                    for (int e = 0; e < 4; ++e) { o0[4 * g + e] *= fv[e]; o1[4 * g + e] *= fv[e]; } }
            }
            float sacc = 0.f;
#pragma unroll
            for (int r = 0; r < 16; ++r) { p0[r] = __builtin_amdgcn_exp2f(p0[r]); p1[r] = __builtin_amdgcn_exp2f(p1[r]); sacc += p0[r] + p1[r]; }
            l += sacc;
            u32x4 pw[4];
#pragma unroll
            for (int i = 0; i < 4; ++i) { pw[0][i] = pk2(p0[2 * i], p0[2 * i + 1]); pw[1][i] = pk2(p0[8 + 2 * i], p0[8 + 2 * i + 1]); pw[2][i] = pk2(p1[2 * i], p1[2 * i + 1]); pw[3][i] = pk2(p1[8 + 2 * i], p1[8 + 2 * i + 1]); }
            const LAS unsigned char* vp = lds + vb0 + slot * VSLOT;
#pragma unroll
            for (int ks = 0; ks < 4; ++ks) {
                const s16x4 a0 = __builtin_bit_cast(s16x4, __builtin_amdgcn_ds_read_tr16_b64_v4i16((LAS v4i16_t*)(vp + ks * 1024)));
                const s16x4 a1 = __builtin_bit_cast(s16x4, __builtin_amdgcn_ds_read_tr16_b64_v4i16((LAS v4i16_t*)(vp + ks * 1024 + 512)));
                const s16x4 b0 = __builtin_bit_cast(s16x4, __builtin_amdgcn_ds_read_tr16_b64_v4i16((LAS v4i16_t*)(vp + 4096 + ks * 1024)));
                const s16x4 b1 = __builtin_bit_cast(s16x4, __builtin_amdgcn_ds_read_tr16_b64_v4i16((LAS v4i16_t*)(vp + 4096 + ks * 1024 + 512)));
                const bf16x8 v0 = (bf16x8){a0[0], a0[1], a0[2], a0[3], a1[0], a1[1], a1[2], a1[3]};
                const bf16x8 v1 = (bf16x8){b0[0], b0[1], b0[2], b0[3], b1[0], b1[1], b1[2], b1[3]};
                const bf16x8 pa = __builtin_bit_cast(bf16x8, pw[ks]);
                o0 = __builtin_amdgcn_mfma_f32_32x32x16_bf16(pa, v0, o0, 0, 0, 0);
                o1 = __builtin_amdgcn_mfma_f32_32x32x16_bf16(pa, v1, o1, 0, 0, 0);
            }
        }
        slot = (slot == 2) ? 0 : slot + 1;
    }
    l += __shfl_xor(l, 32);
    if (hi == 0) wsf[r32] = __builtin_amdgcn_rcpf(l);
    asm volatile("s_waitcnt lgkmcnt(0)" ::: "memory");
    LAS bf16_t* stg = (LAS bf16_t*)(lds + L_OST) + wid * 2048;
#pragma unroll
    for (int g = 0; g < 4; ++g) { const f32x4 fv = *(const LAS f32x4*)(wsf + 8 * g + 4 * hi);
#pragma unroll
        for (int e = 0; e < 4; ++e) { const int r = 4 * g + e, orow = crow(r, hi);
            stg[orow * 64 + r32] = f2bf(o0[r] * fv[e]); stg[orow * 64 + 32 + r32] = f2bf(o1[r] * fv[e]); } }
    asm volatile("s_waitcnt lgkmcnt(0)" ::: "memory");
    bf16_t* Ow = MIX + (tb + q0 + wid * 32) * 1024 + 512 + h * 64;
#pragma unroll
    for (int i = 0; i < 4; ++i) { const int row = i * 8 + (lane >> 3), ch = lane & 7; const u32x4 v = *(const LAS u32x4*)(stg + row * 64 + ch * 8); *(u32x4*)(Ow + (size_t)row * 1024 + ch * 8) = v; }
    ATT_WAIT_V(0);
    ATT_BAR();
#undef ATT_DMA
}
}

namespace ret {
using att::f32x16; using att::s16x4; using att::v4i16_t; using att::crow; using pg8::pack8;
__device__ __forceinline__ float sfloat(float v) { return __uint_as_float(__builtin_amdgcn_readfirstlane(__float_as_uint(v))); }
__device__ __forceinline__ float lg2gamma(int h) { return sfloat(log1pf(-exp2f(-5.0f - (float)h)) * 1.4426950408889634f); }
__device__ __forceinline__ bf16x8 trfrag(const LAS unsigned char* p) {
    const s16x4 a = __builtin_bit_cast(s16x4, __builtin_amdgcn_ds_read_tr16_b64_v4i16((LAS v4i16_t*)p));
    const s16x4 b = __builtin_bit_cast(s16x4, __builtin_amdgcn_ds_read_tr16_b64_v4i16((LAS v4i16_t*)(p + 512)));
    return (bf16x8){a[0], a[1], a[2], a[3], b[0], b[1], b[2], b[3]};
}
__device__ __forceinline__ u32x4 scale8(u32x4 v, float z) {
    u32x4 o;
#pragma unroll
    for (int i = 0; i < 4; ++i) { const float lo = __uint_as_float(v[i] << 16) * z, hi = __uint_as_float(v[i] & 0xffff0000u) * z; o[i] = pk2(lo, hi); }
    return o;
}
__device__ __forceinline__ void states_unit(int b, int h, int g, const bf16_t* __restrict__ RK, const bf16_t* __restrict__ RV, float* __restrict__ LST, float* __restrict__ GST, LAS unsigned char* lds, int wave_s) {
    const int tid_ = (wave_s << 6) | lane_id_v();
    const int lane = tid_ & 63, r32 = lane & 31, hi = lane >> 5, wid = wave_s;
    const int n = 8 * g + wid; const size_t tb = (size_t)b * SEQ + (size_t)n * 128;
    LAS unsigned char* my = lds + wid * 16384;
    const float lg2 = lg2gamma(h);
    const int vb = ((lane >> 4) & 1) * 32 + (lane & 3) * 8 + (4 * hi + ((lane & 15) >> 2)) * 64;
    f32x16 s00, s01, s10, s11;
#pragma unroll
    for (int r = 0; r < 16; ++r) { s00[r] = 0.f; s01[r] = 0.f; s10[r] = 0.f; s11[r] = 0.f; }
    for (int half = 0; half < 2; ++half) {
#pragma unroll
        for (int i = 0; i < 8; ++i) { const int p = lane + 64 * i, tok = p >> 3, c = p & 7; const size_t go = (tb + 64 * half + tok) * 512 + h * 64 + c * 8;
            const u32x4 kv = *(const u32x4*)(RK + go), vv = *(const u32x4*)(RV + go);
            const float z = exp2f(lg2 * (float)(127 - (64 * half + tok)));
            const int off = (c >> 2) * 4096 + tok * 64 + (c & 3) * 16;
            *(LAS u32x4*)(my + off) = scale8(kv, z); *(LAS u32x4*)(my + 8192 + off) = vv; }
        asm volatile("s_waitcnt lgkmcnt(0)" ::: "memory");
#pragma unroll
        for (int ks = 0; ks < 4; ++ks) {
            const bf16x8 ka0 = trfrag(my + vb + ks * 1024), ka1 = trfrag(my + vb + 4096 + ks * 1024);
            const bf16x8 vb0 = trfrag(my + 8192 + vb + ks * 1024), vb1 = trfrag(my + 8192 + vb + 4096 + ks * 1024);
            s00 = __builtin_amdgcn_mfma_f32_32x32x16_bf16(ka0, vb0, s00, 0, 0, 0); s01 = __builtin_amdgcn_mfma_f32_32x32x16_bf16(ka0, vb1, s01, 0, 0, 0);
            s10 = __builtin_amdgcn_mfma_f32_32x32x16_bf16(ka1, vb0, s10, 0, 0, 0); s11 = __builtin_amdgcn_mfma_f32_32x32x16_bf16(ka1, vb1, s11, 0, 0, 0);
        }
        asm volatile("s_waitcnt lgkmcnt(0)" ::: "memory");
    }
    LAS float* st = (LAS float*)my;
#pragma unroll
    for (int g4 = 0; g4 < 4; ++g4) {
        *(LAS f32x4*)(st + (r32) * 64 + 8 * g4 + 4 * hi) = (f32x4){s00[4 * g4], s00[4 * g4 + 1], s00[4 * g4 + 2], s00[4 * g4 + 3]};
        *(LAS f32x4*)(st + (r32) * 64 + 32 + 8 * g4 + 4 * hi) = (f32x4){s10[4 * g4], s10[4 * g4 + 1], s10[4 * g4 + 2], s10[4 * g4 + 3]};
        *(LAS f32x4*)(st + (32 + r32) * 64 + 8 * g4 + 4 * hi) = (f32x4){s01[4 * g4], s01[4 * g4 + 1], s01[4 * g4 + 2], s01[4 * g4 + 3]};
        *(LAS f32x4*)(st + (32 + r32) * 64 + 32 + 8 * g4 + 4 * hi) = (f32x4){s11[4 * g4], s11[4 * g4 + 1], s11[4 * g4 + 2], s11[4 * g4 + 3]};
    }
    asm volatile("s_waitcnt lgkmcnt(0)" ::: "memory"); __builtin_amdgcn_s_barrier(); asm volatile("" ::: "memory");
    const float cd = sfloat(exp2f(lg2 * 128.0f));
    const size_t ub = (size_t)((b * 8 + h) * 64 + 8 * g) * 4096;
#pragma unroll
    for (int i = 0; i < 8; ++i) { const int idx = tid_ + 512 * i; float R = 0.f;
#pragma unroll
        for (int w = 0; w < 8; ++w) { const float sv = *(const LAS float*)(lds + w * 16384 + idx * 4); LST[ub + (size_t)w * 4096 + idx] = R; R = cd * R + sv; }
        GST[(size_t)((b * 8 + h) * 8 + g) * 4096 + idx] = R; }
    asm volatile("s_waitcnt lgkmcnt(0)" ::: "memory"); __builtin_amdgcn_s_barrier(); asm volatile("" ::: "memory");
}

constexpr int RO_WSTRIDE = 16896, RO_OST = 8192, RO_PG = 8 * RO_WSTRIDE;
static_assert(RO_PG + 16384 <= 155648, "retention LDS");
__device__ __forceinline__ void out_unit(int b, int h, int g, const bf16_t* __restrict__ RQ, const bf16_t* __restrict__ RK, const bf16_t* __restrict__ RV, const bf16_t* __restrict__ RG,
        const float* __restrict__ LST, const float* __restrict__ GST, const float* __restrict__ gnw, bf16_t* __restrict__ MIX, LAS unsigned char* lds, int wave_s) {
    const int tid_ = (wave_s << 6) | lane_id_v();
    const int lane = tid_ & 63, r32 = lane & 31, hi = lane >> 5, wid = wave_s;
    const float lg2 = lg2gamma(h);
    LAS float* PG = (LAS float*)(lds + RO_PG);
    { const float cd8 = sfloat(exp2f(lg2 * 1024.0f));
#pragma unroll
      for (int i = 0; i < 8; ++i) { const int idx = tid_ + 512 * i; float R = 0.f;
          for (int gp = 0; gp < g; ++gp) R = cd8 * R + GST[(size_t)((b * 8 + h) * 8 + gp) * 4096 + idx];
          PG[idx] = R; } }
    asm volatile("s_waitcnt lgkmcnt(0)" ::: "memory"); __builtin_amdgcn_s_barrier(); asm volatile("" ::: "memory");
    const int n = 8 * g + wid; const size_t tb = (size_t)b * SEQ + (size_t)n * 128;
    LAS unsigned char* my = lds + wid * RO_WSTRIDE;
    LAS float* ost = (LAS float*)(my + RO_OST);
    const int vb = ((lane >> 4) & 1) * 32 + (lane & 3) * 8 + (4 * hi + ((lane & 15) >> 2)) * 64;
    const float* Ln = LST + (size_t)((b * 8 + h) * 64 + n) * 4096;
    const float scw = sfloat(exp2f(lg2 * (float)(128 * wid))), gam = sfloat(exp2f(lg2));
    f32x16 o0, o1; bf16x8 kf[4][2];
    int cur_kt = -1;
    for (int stp = 0; stp < 6; ++stp) {
        const int kt = (stp == 3 || stp == 4) ? 1 : 0; const int qi = stp < 3 ? stp : (stp == 3 ? 2 : 3); const bool init = (stp != 3 && stp != 5), fin = (stp != 2 && stp != 4);
        if (kt != cur_kt) {
            asm volatile("s_waitcnt lgkmcnt(0)" ::: "memory");
#pragma unroll
            for (int i = 0; i < 8; ++i) { const int p = lane + 64 * i, tok = p >> 3, c = p & 7;
                *(LAS u32x4*)(my + (c >> 2) * 4096 + tok * 64 + (c & 3) * 16) = *(const u32x4*)(RV + (tb + 64 * kt + tok) * 512 + h * 64 + c * 8); }
#pragma unroll
            for (int d0 = 0; d0 < 4; ++d0)
#pragma unroll
                for (int hf = 0; hf < 2; ++hf) kf[d0][hf] = *(const bf16x8*)(RK + (tb + 64 * kt + 32 * hf + r32) * 512 + h * 64 + 16 * d0 + 8 * hi);
            cur_kt = kt;
            asm volatile("s_waitcnt lgkmcnt(0)" ::: "memory");
        }
        bf16x8 qf[4];
#pragma unroll
        for (int d0 = 0; d0 < 4; ++d0) qf[d0] = *(const bf16x8*)(RQ + (tb + 32 * qi + r32) * 512 + h * 64 + 16 * d0 + 8 * hi);
        if (init) {
#pragma unroll
            for (int r = 0; r < 16; ++r) { o0[r] = 0.f; o1[r] = 0.f; } }
        {
            f32x16 p0, p1;
#pragma unroll
            for (int r = 0; r < 16; ++r) { p0[r] = 0.f; p1[r] = 0.f; }
#pragma unroll
            for (int d0 = 0; d0 < 4; ++d0) { p0 = __builtin_amdgcn_mfma_f32_32x32x16_bf16(kf[d0][0], qf[d0], p0, 0, 0, 0); p1 = __builtin_amdgcn_mfma_f32_32x32x16_bf16(kf[d0][1], qf[d0], p1, 0, 0, 0); }
            const int qrel = 32 * qi + r32;
#pragma unroll
            for (int r = 0; r < 16; ++r) { const int key = 64 * kt + crow(r, hi);
                const float bk = __builtin_amdgcn_exp2f(-lg2 * (float)key), bk2 = __builtin_amdgcn_exp2f(-lg2 * (float)(key + 32));
                p0[r] = (key <= qrel) ? p0[r] * bk : 0.f; p1[r] = (key + 32 <= qrel) ? p1[r] * bk2 : 0.f; }
            u32x4 pw[4];
#pragma unroll
            for (int i = 0; i < 4; ++i) { pw[0][i] = pk2(p0[2 * i], p0[2 * i + 1]); pw[1][i] = pk2(p0[8 + 2 * i], p0[8 + 2 * i + 1]); pw[2][i] = pk2(p1[2 * i], p1[2 * i + 1]); pw[3][i] = pk2(p1[8 + 2 * i], p1[8 + 2 * i + 1]); }
#pragma unroll
            for (int ks = 0; ks < 4; ++ks) { const bf16x8 v0 = trfrag(my + vb + ks * 1024), v1 = trfrag(my + vb + 4096 + ks * 1024); const bf16x8 pa = __builtin_bit_cast(bf16x8, pw[ks]);
                o0 = __builtin_amdgcn_mfma_f32_32x32x16_bf16(pa, v0, o0, 0, 0, 0); o1 = __builtin_amdgcn_mfma_f32_32x32x16_bf16(pa, v1, o1, 0, 0, 0); }
        }
        if (fin) {
#pragma unroll
            for (int s = 0; s < 4; ++s) {
#pragma unroll
                for (int eb = 0; eb < 2; ++eb) { const int eo = (32 * eb + r32) * 64 + 16 * s + 8 * hi;
                    const f32x4 la = *(const f32x4*)(Ln + eo), lb = *(const f32x4*)(Ln + eo + 4); const f32x4 pa = *(const LAS f32x4*)(PG + eo), pb = *(const LAS f32x4*)(PG + eo + 4);
                    const f32x4 ra = (la + pa * scw) * gam, rbv = (lb + pb * scw) * gam;
                    const bf16x8 rf = __builtin_bit_cast(bf16x8, pack8(ra, rbv));
                    if (eb == 0) o0 = __builtin_amdgcn_mfma_f32_32x32x16_bf16(qf[s], rf, o0, 0, 0, 0); else o1 = __builtin_amdgcn_mfma_f32_32x32x16_bf16(qf[s], rf, o1, 0, 0, 0); }
            }
#pragma unroll
            for (int r = 0; r < 16; ++r) { const int q = crow(r, hi); const float rf = __builtin_amdgcn_exp2f(lg2 * (float)(32 * qi + q)); ost[q * 68 + r32] = o0[r] * rf; ost[q * 68 + 32 + r32] = o1[r] * rf; }
            asm volatile("s_waitcnt lgkmcnt(0)" ::: "memory");
            const int q = lane >> 1, hf = lane & 1; f32x4 v[8]; float sm = 0.f;
#pragma unroll
            for (int i = 0; i < 8; ++i) { v[i] = *(const LAS f32x4*)(ost + q * 68 + hf * 32 + 4 * i); sm += (v[i][0] + v[i][1]) + (v[i][2] + v[i][3]); }
            sm += __shfl_xor(sm, 1); const float mu = sm * (1.0f / 64); float vr = 0.f;
#pragma unroll
            for (int i = 0; i < 8; ++i) { v[i] = v[i] - mu; vr += (v[i][0] * v[i][0] + v[i][1] * v[i][1]) + (v[i][2] * v[i][2] + v[i][3] * v[i][3]); }
            vr += __shfl_xor(vr, 1); const float rstd = rsqrtf(vr * (1.0f / 64) + EPS);
            const size_t t = tb + 32 * qi + q;
            const u32x4* gp = (const u32x4*)(RG + t * 512 + h * 64 + hf * 32); const f32x4* wp = (const f32x4*)(gnw + h * 64 + hf * 32);
            u32x4* op = (u32x4*)(MIX + t * 1024 + h * 64 + hf * 32);
#pragma unroll
            for (int i = 0; i < 4; ++i) { const u32x4 gv = gp[i]; const f32x4 wa = wp[2 * i], wb = wp[2 * i + 1]; f32x4 ya, yb;
#pragma unroll
                for (int e = 0; e < 4; ++e) { const float ga = __uint_as_float(gv[e] << 16), gb = __uint_as_float(gv[e] & 0xffff0000u);
                    const float sa = ga * __builtin_amdgcn_rcpf(1.0f + __builtin_amdgcn_exp2f(-1.4426950408889634f * ga)), sb = gb * __builtin_amdgcn_rcpf(1.0f + __builtin_amdgcn_exp2f(-1.4426950408889634f * gb));
                    const int j0 = 2 * e, j1 = 2 * e + 1;
                    const float x0 = (j0 < 4 ? v[2 * i][j0] : v[2 * i + 1][j0 - 4]) * rstd * (j0 < 4 ? wa[j0] : wb[j0 - 4]);
                    const float x1 = (j1 < 4 ? v[2 * i][j1] : v[2 * i + 1][j1 - 4]) * rstd * (j1 < 4 ? wa[j1] : wb[j1 - 4]);
                    if (e < 2) { ya[2 * e] = sa * x0; ya[2 * e + 1] = sb * x1; } else { yb[2 * (e - 2)] = sa * x0; yb[2 * (e - 2) + 1] = sb * x1; } }
                op[i] = pack8(ya, yb); }
        }
    }
    asm volatile("s_waitcnt vmcnt(0) lgkmcnt(0)" ::: "memory"); __builtin_amdgcn_s_barrier(); asm volatile("" ::: "memory");
}
}

#define LDS_WAIT() asm volatile("s_waitcnt lgkmcnt(0)" ::: "memory")
#define VM_WAIT() asm volatile("s_waitcnt vmcnt(0)" ::: "memory")
#define XB_TMO      128
#define XB_XCNT(j)  (256  + 64 * (j))
#define XB_XSUB(j)  (1280 + 64 * (j))
#define XB_XGEN(j)  (2304 + 64 * (j))
#define XB_TOP      3328
#define XB_TOPGEN   3392
#define XCD_BAR_WORDS 3456
#define XB_SPIN_CAP (1u << 18)
__device__ __forceinline__ unsigned xb_ld(unsigned* p)              { return __hip_atomic_load(p, __ATOMIC_RELAXED, __HIP_MEMORY_SCOPE_AGENT); }
__device__ __forceinline__ unsigned xb_add(unsigned* p, unsigned v) { return __hip_atomic_fetch_add(p, v, __ATOMIC_RELAXED, __HIP_MEMORY_SCOPE_AGENT); }
__device__ __forceinline__ unsigned xb_xcc_id() { return (unsigned)__builtin_amdgcn_s_getreg((3 << 11) | 20) & 0xFu; }
#define XB_SPIN(cond, bar) do { unsigned _sp = 0; while (cond) { __builtin_amdgcn_s_sleep(1); \
    if ((++_sp & 255u) == 0u) { if (xb_ld(&(bar)[XB_TMO])) break; if (_sp > XB_SPIN_CAP) { atomicAdd(&(bar)[XB_TMO], 1u); break; } } } } while (0)
struct XcdBarrier { unsigned* bar; unsigned x; volatile LAS unsigned* st; };
__device__ __forceinline__ XcdBarrier xcd_barrier_post(unsigned* bar, volatile LAS unsigned* st, int wave_s) {
    XcdBarrier b; b.bar = bar; b.x = xb_xcc_id(); b.st = st;
    if (((wave_s << 6) | lane_id_v()) == 0) (void)xb_add(&bar[XB_XCNT(b.x)], 1u);
    return b;
}
__device__ __forceinline__ void xcd_barrier_complete(unsigned* bar, unsigned x, unsigned& nloc, unsigned& nx) {
    const unsigned G = gridDim.x * gridDim.y * gridDim.z;
    unsigned sum, cnt, mine, sp = 0u;
    for (;;) {
        sum = 0u; cnt = 0u; mine = 0u;
#pragma unroll
        for (unsigned j = 0; j < 16; ++j) { const unsigned c = xb_ld(&bar[XB_XCNT(j)]); sum += c; cnt += (c > 0u) ? 1u : 0u; mine = (j == x) ? c : mine; }
        if (sum == G) break;
        __builtin_amdgcn_s_sleep(1);
        if ((++sp & 255u) == 0u) { if (xb_ld(&bar[XB_TMO])) break; if (sp > XB_SPIN_CAP) { atomicAdd(&bar[XB_TMO], 1u); break; } }
    }
    nloc = mine > 0u ? mine : 1u; nx = cnt > 0u ? cnt : 1u;
}
__device__ __forceinline__ void xcd_barrier(const XcdBarrier& b, int wave_s) {
    asm volatile("s_waitcnt vmcnt(0)" ::: "memory");
    __syncthreads();
    if (((wave_s << 6) | lane_id_v()) == 0) {
        unsigned* bar = b.bar;
        __builtin_amdgcn_s_waitcnt(0);
        unsigned nloc = b.st[0], nx = b.st[1];
        if (nloc == 0u) { xcd_barrier_complete(bar, b.x, nloc, nx); b.st[0] = nloc; b.st[1] = nx; }
        const unsigned old = xb_add(&bar[XB_XSUB(b.x)], 1u);
        const unsigned gen = old / nloc;
        if (old + 1u == (gen + 1u) * nloc) {
            __builtin_amdgcn_fence(__ATOMIC_RELEASE, "agent");
            asm volatile("s_waitcnt vmcnt(0)" ::: "memory");
            const unsigned og = xb_add(&bar[XB_TOP], 1u);
            const unsigned tg = og / nx;
            if (og + 1u == (tg + 1u) * nx) xb_add(&bar[XB_TOPGEN], 1u);
            else XB_SPIN(xb_ld(&bar[XB_TOPGEN]) == tg, bar);
            __builtin_amdgcn_fence(__ATOMIC_ACQUIRE, "agent");
            xb_add(&bar[XB_XGEN(b.x)], 1u);
            asm volatile("s_waitcnt vmcnt(0)" ::: "memory");
        } else {
            XB_SPIN(xb_ld(&bar[XB_XGEN(b.x)]) == gen, bar);
            __builtin_amdgcn_fence(__ATOMIC_ACQUIRE, "agent");
            asm volatile("s_waitcnt vmcnt(0)" ::: "memory");
        }
    }
    __syncthreads();
}

constexpr int NWAVES = 8;
constexpr int RING_OFF = 0, RING_BYTES = 131072;
constexpr int XCH_OFF = RING_BYTES, XCH_BYTES = 24576;
constexpr int LDSCTL_OFF = XCH_OFF + XCH_BYTES, MISC_OFF = LDSCTL_OFF + 320;
constexpr int MK_LDS_BYTES = 160 * 1024;
static_assert(MISC_OFF + 128 <= MK_LDS_BYTES, "LDS map");
constexpr int CW_BAR = 4096;
constexpr size_t CTL_ZERO_BYTES = 1 * MiB;

struct Args { const void* in[16]; float* out; unsigned char* ws; int ph_lo, ph_hi, li, pad; };

__device__ __forceinline__ int src_win(int n) {
    const int pn = n >> 8, j = n & 255, bj = j >> 7, wc = (j >> 5) & 3, w = j & 31;
    if (pn < 4) return 256 * pn + 64 * wc + 32 * bj + w;
    if (pn < 9) return n;
    if (j < 128) return 2304 + j;
    if (j < 160) return 2432 + 16 * ((w >> 2) & 1) + 4 * (w >> 3) + (w & 3);
    return -1;
}
__device__ __forceinline__ int src_wuq(int n) {
    if (n < 512) return (n >> 6) * 96 + (n & 63);
    const int j = n & 255, bj = j >> 7, wc = (j >> 5) & 3, w = j & 31;
    return (4 * bj + wc) * 96 + 64 + 16 * ((w >> 2) & 1) + 4 * (w >> 3) + (w & 3);
}
__device__ __forceinline__ int src_wup(int n) { const int tile = n >> 8, j = n & 255; return (j >> 7) * FF + tile * 128 + (j & 127); }
template <int WHICH> __device__ __forceinline__ int src_col(int n) { if (WHICH == 0) return src_win(n); if (WHICH == 1) return src_wuq(n); if (WHICH == 2) return src_wup(n); return n; }
template <int WHICH> __device__ __forceinline__ void p0_transpose_item(const float* __restrict__ W, int K, int Nsrc, const float* __restrict__ gain, bf16_t* WT, LAS float* scr, int item, int nblk, int lane) {
    const int kb = item / nblk, nb = item % nblk, k0 = 64 * kb, n0 = 32 * nb;
    const int sc = src_col<WHICH>(n0 + (lane & 31));
#pragma unroll 8
    for (int i = 0; i < 32; ++i) { const int kk = 2 * i + (lane >> 5); float v = 0.f; if (sc >= 0) v = W[(size_t)(k0 + kk) * Nsrc + sc]; if (gain) v *= gain[k0 + kk]; scr[kk * 33 + (lane & 31)] = v; }
    LDS_WAIT(); asm volatile("" ::: "memory");
    const int c = lane & 7;
#pragma unroll
    for (int j = 0; j < 4; ++j) { const int n = (lane >> 3) + 8 * j; const LAS float* s = scr + (8 * c) * 33 + n;
        u32x4 o; o.x = pk2(s[0 * 33], s[1 * 33]); o.y = pk2(s[2 * 33], s[3 * 33]); o.z = pk2(s[4 * 33], s[5 * 33]); o.w = pk2(s[6 * 33], s[7 * 33]);
        *(u32x4*)(WT + (size_t)(n0 + n) * K + k0 + 8 * c) = o; }
    LDS_WAIT(); asm volatile("" ::: "memory");
}
__device__ __forceinline__ void rope_entry(const int* __restrict__ pos, float2* rt_ret, float2* rt_mla, int idx) {
    const int t = idx / 48, j = idx % 48;
    const bool mla = j >= 32; const int i = mla ? j - 32 : j;
    const double ex = mla ? -(double)i / 16.0 : -(double)i / 32.0;
    const float inv = (float)exp2(ex * 13.287712379549449);
    const float ang = (float)pos[t] * inv;
    const double a = (double)ang;
    const double n = rint(a * 0.6366197723675814);
    const double r = a - n * 1.5707963267948966;
    const double r2 = r * r;
    const double sn = r + r * r2 * (-1.0 / 6 + r2 * (1.0 / 120 + r2 * (-1.0 / 5040 + r2 * (1.0 / 362880 - r2 / 39916800.0))));
    const double cs = 1.0 + r2 * (-0.5 + r2 * (1.0 / 24 + r2 * (-1.0 / 720 + r2 * (1.0 / 40320 + r2 * (-1.0 / 3628800 + r2 / 479001600.0)))));
    const int q = ((int)n) & 3;
    float c, s;
    if (q == 0) { c = (float)cs; s = (float)sn; } else if (q == 1) { c = (float)-sn; s = (float)cs; } else if (q == 2) { c = (float)-cs; s = (float)-sn; } else { c = (float)sn; s = (float)-cs; }
    if (mla) rt_mla[t * 16 + i] = make_float2(c, s); else rt_ret[t * 32 + i] = make_float2(c, s);
}

#ifndef RET_NAIVE
#define RET_NAIVE 0
#endif
#ifndef OPT_MASK
#define OPT_MASK 0xFF
#endif

__global__ void __launch_bounds__(NWAVES * 64, 2) mk_fwd(Args args) {
    extern __shared__ __attribute__((aligned(16))) unsigned char lds_raw[];
    LAS unsigned char* lds = (LAS unsigned char*)lds_raw;
    volatile LAS unsigned* MISC = (volatile LAS unsigned*)(lds + MISC_OFF);
    const int wave_s = __builtin_amdgcn_readfirstlane(threadIdx.x >> 6);
    const int G = gridDim.x; const int bx = blockIdx.x; const int vcu = (G % 8 == 0) ? (bx % 8) * (G / 8) + bx / 8 : bx;
    unsigned char* ws = args.ws;
    unsigned* ctl = (unsigned*)(ws + WS_CTL);
    { const int t0_ = (wave_s << 6) | lane_id_v(); for (int u = t0_; u < (MK_LDS_BYTES - LDSCTL_OFF) / 4; u += NWAVES * 64) ((LAS unsigned*)(lds + LDSCTL_OFF))[u] = 0u; }
    __syncthreads();
    const int lo = args.ph_lo, hi = args.ph_hi;
    XcdBarrier bar; bar.bar = ctl + CW_BAR + args.li * XCD_BAR_WORDS; bar.x = 0; bar.st = nullptr;
    if (hi - lo > 1) bar = xcd_barrier_post(ctl + CW_BAR + args.li * XCD_BAR_WORDS, MISC + 8, wave_s);
#define IN(k) (lo <= (k) && (k) < hi)
#define SEAM(k) do { if (IN(k) && IN((k) + 1)) xcd_barrier(bar, wave_s); } while (0)
#define PHASE_IDS() const int tidp_ = (wave_s << 6) | lane_id_v(); const int lane = tidp_ & 63, wave = wave_s; const int gw = vcu * NWAVES + wave, NGW = G * NWAVES; (void)lane; (void)gw; (void)NGW

    if (IN(0)) {
        PHASE_IDS();
        const float* x = (const float*)args.in[0]; const int* pos = (const int*)args.in[1];
        const float* attn_nw = (const float*)args.in[2]; const float* w_in = (const float*)args.in[3];
        const float* qnw = (const float*)args.in[5]; const float* w_uq = (const float*)args.in[6]; const float* kvnw = (const float*)args.in[7]; const float* w_ukv = (const float*)args.in[8];
        const float* w_out = (const float*)args.in[9]; const float* fnw = (const float*)args.in[10]; const float* w_up = (const float*)args.in[11]; const float* w_down = (const float*)args.in[14];
        float2* rt_ret = (float2*)(ws + WS_RTRET); float2* rt_mla = (float2*)(ws + WS_RTMLA);
        bf16_t *XB = (bf16_t*)(ws + WS_XB), *WIN = (bf16_t*)(ws + WS_WIN), *WUQ = (bf16_t*)(ws + WS_WUQ), *WUKV = (bf16_t*)(ws + WS_WUKV), *WOUT = (bf16_t*)(ws + WS_WOUT), *WUP = (bf16_t*)(ws + WS_WUP), *WDOWN = (bf16_t*)(ws + WS_WDOWN);
        float* RS1 = (float*)(ws + WS_RS1);
        LAS float* scr = (LAS float*)(lds + RING_OFF + wave * 16384);
        constexpr int I_IN = 16 * 80, I_UQ = 4 * 24, I_UKV = 2 * 32, I_OUT = 16 * 32, I_UP = 16 * 176, I_DOWN = 44 * 32;
        constexpr int NITEMS = I_IN + I_UQ + I_UKV + I_OUT + I_UP + I_DOWN;
        for (int it = gw; it < NITEMS; it += NGW) {
            int r = it;
            if (r < I_IN) { p0_transpose_item<0>(w_in, 1024, INW, attn_nw, WIN, scr, r, 80, lane); continue; } r -= I_IN;
            if (r < I_UQ) { p0_transpose_item<1>(w_uq, 256, 768, qnw, WUQ, scr, r, 24, lane); continue; } r -= I_UQ;
            if (r < I_UKV) { p0_transpose_item<3>(w_ukv, 128, 1024, kvnw, WUKV, scr, r, 32, lane); continue; } r -= I_UKV;
            if (r < I_OUT) { p0_transpose_item<3>(w_out, 1024, 1024, nullptr, WOUT, scr, r, 32, lane); continue; } r -= I_OUT;
            if (r < I_UP) { p0_transpose_item<2>(w_up, 1024, FF2, fnw, WUP, scr, r, 176, lane); continue; } r -= I_UP;
            p0_transpose_item<3>(w_down, FF, 1024, nullptr, WDOWN, scr, r, 32, lane);
        }
        for (int m = gw; m < NT; m += NGW) {
            const f32x4* xr = (const f32x4*)(x + (size_t)m * DM) + lane; f32x4 v[4]; float s = 0.f;
#pragma unroll
            for (int j = 0; j < 4; ++j) { v[j] = xr[64 * j]; s += (v[j][0] * v[j][0] + v[j][1] * v[j][1]) + (v[j][2] * v[j][2] + v[j][3] * v[j][3]); }
            s = wave_sum(s); if (lane == 0) RS1[m] = rsqrtf(s * (1.0f / DM) + EPS);
            u32x2* o8 = (u32x2*)(XB + (size_t)m * DM) + lane;
#pragma unroll
            for (int j = 0; j < 4; ++j) { u32x2 w; w.x = pk2(v[j][0], v[j][1]); w.y = pk2(v[j][2], v[j][3]); o8[64 * j] = w; }
        }
        for (int idx = vcu * 512 + tidp_; idx < NT * 48; idx += G * 512) rope_entry(pos, rt_ret, rt_mla, idx);
    }
    SEAM(0);
    if (IN(1)) {
        pg8::Gemm g{(const bf16_t*)(ws + WS_XB), (const bf16_t*)(ws + WS_WIN), 128, 10, 1024, 0}; pg8::StaticOrder S; S.init(128, 10, G, bx);
        pg8::EpiInProj E{ws};
        pg8::gemm_phase<pg8::EpiInProj, true, true>(lds + RING_OFF, g, S, E, wave_s);
    }
    SEAM(1);
    if (IN(2)) {
        if (!RET_NAIVE) { for (int v = vcu; v < 256; v += G) ret::states_unit(v >> 6, (v >> 3) & 7, v & 7, (const bf16_t*)(ws + WS_RK), (const bf16_t*)(ws + WS_RV), (float*)(ws + WS_NS), (float*)(ws + WS_GST), lds, wave_s); }
        { pg8::Gemm g{(const bf16_t*)(ws + WS_CQ), (const bf16_t*)(ws + WS_WUQ), 128, 3, 256, 0}; pg8::StaticOrder S; S.init(128, 3, G, bx);
          pg8::EpiQUp E{ws};
          pg8::gemm_phase<pg8::EpiQUp, true, true>(lds + RING_OFF, g, S, E, wave_s); }
        { pg8::Gemm g{(const bf16_t*)(ws + WS_CKV), (const bf16_t*)(ws + WS_WUKV), 128, 4, 128, 0}; pg8::StaticOrder S; S.init(128, 4, G, bx);
          pg8::EpiKVUp E{ws};
          pg8::gemm_phase<pg8::EpiKVUp, true, true>(lds + RING_OFF, g, S, E, wave_s); }
    }
    SEAM(2);
    if (IN(3)) {
        const bf16_t* QB = (const bf16_t*)(ws + WS_QB); const bf16_t* KVB = (const bf16_t*)(ws + WS_KVB); const bf16_t* KPE = (const bf16_t*)(ws + WS_KPE); bf16_t* MIX = (bf16_t*)(ws + WS_MIX);
        if (!RET_NAIVE) { for (int v = vcu; v < 256; v += G) ret::out_unit(v >> 6, (v >> 3) & 7, v & 7, (const bf16_t*)(ws + WS_RQ), (const bf16_t*)(ws + WS_RK), (const bf16_t*)(ws + WS_RV), (const bf16_t*)(ws + WS_RG),
            (const float*)(ws + WS_NS), (const float*)(ws + WS_GST), (const float*)args.in[4], MIX, lds, wave_s); }
        for (int v = vcu; v < 256; v += G) {
            const int bh = v >> 3, s = v & 7;
            for (int i = 0; i < 4; ++i) { const int qb = (i == 0) ? s : (i == 1) ? 15 - s : (i == 2) ? 16 + s : 31 - s;
                att::attn_unit(bh >> 3, bh & 7, qb, QB, KVB, KPE, MIX, lds + RING_OFF, wave_s); }
        }
    }
    SEAM(3);
    if (IN(4)) {
        if (bx < NB) { const int t4_ = (wave_s << 6) | lane_id_v(); for (int i = t4_; i < 2048 / 8; i += NWAVES * 64) *(u32x4*)((bf16_t*)(ws + WS_X1B) + (size_t)bx * SEQP * 1024 + i * 8) = (u32x4){0u, 0u, 0u, 0u}; }
        pg8::Gemm g{(const bf16_t*)(ws + WS_MIX), (const bf16_t*)(ws + WS_WOUT), 128, 4, 1024, 0}; pg8::StaticOrder S; S.init(128, 4, G, bx);
        pg8::EpiResid<true> E{(const float*)args.in[0], args.out, ws};
        pg8::gemm_phase<pg8::EpiResid<true>, true, true>(lds + RING_OFF, g, S, E, wave_s);
    }
    SEAM(4);
    if (IN(5)) {
        pg8::Gemm g{(const bf16_t*)(ws + WS_X1B), (const bf16_t*)(ws + WS_WUP), 132, 22, 1024, 1}; pg8::StaticOrder S; S.init(132, 22, G, bx);
        pg8::EpiUpConv E{ws, (const float*)args.in[12], (const float*)args.in[13], lds + XCH_OFF};
        pg8::gemm_phase<pg8::EpiUpConv, true, true>(lds + RING_OFF, g, S, E, wave_s);
    }
    SEAM(5);
    if (IN(6)) {
        pg8::Gemm g{(const bf16_t*)(ws + WS_ACT), (const bf16_t*)(ws + WS_WDOWN), 128, 4, FF, 0}; pg8::StaticOrder S; S.init(128, 4, G, bx);
        pg8::EpiResid<false> E{args.out, args.out, ws};
        pg8::gemm_phase<pg8::EpiResid<false>, true, true>(lds + RING_OFF, g, S, E, wave_s);
    }
    SEAM(6);
    if (IN(7)) {
        PHASE_IDS();
        float* out = args.out; const float* final_w = (const float*)args.in[15]; const float* SS3 = (const float*)(ws + WS_SS3);
        for (int m = gw; m < NT; m += NGW) {
            const f32x4* sp = (const f32x4*)(SS3 + (size_t)m * 16); const f32x4 a = sp[0], b = sp[1], c = sp[2], d = sp[3];
            const float s = ((a[0] + a[1]) + (a[2] + a[3])) + ((b[0] + b[1]) + (b[2] + b[3])) + ((c[0] + c[1]) + (c[2] + c[3])) + ((d[0] + d[1]) + (d[2] + d[3]));
            const float rs = rsqrtf(s * (1.0f / 1024) + EPS);
            f32x4* xr = (f32x4*)(out + (size_t)m * DM) + lane; const f32x4* wr = (const f32x4*)final_w + lane;
#pragma unroll
            for (int j = 0; j < 4; ++j) xr[64 * j] = xr[64 * j] * wr[64 * j] * rs;
        }
    }
#undef IN
#undef SEAM
}

extern "C" void kernel_launch(void* const* d_in, const int* in_sizes, int n_in, void* d_out, int out_size, void* d_ws, size_t ws_size, hipStream_t stream) {
    static int grid = 0;
    if (grid == 0) {
        if (n_in != 16 || in_sizes[0] != NT * DM || out_size != NT * DM || ws_size < WS_END) { fprintf(stderr, "kernel_launch: unexpected shapes (n_in %d, ws %zu)\n", n_in, ws_size); grid = -1; return; }
        (void)hipFuncSetAttribute((const void*)nk3_out, hipFuncAttributeMaxDynamicSharedMemorySize, NK3O_LDS);
        if (hipFuncSetAttribute((const void*)mk_fwd, hipFuncAttributeMaxDynamicSharedMemorySize, MK_LDS_BYTES) != hipSuccess) { fprintf(stderr, "kernel_launch: hipFuncSetAttribute(mk_fwd) failed\n"); grid = -1; return; }
        int dev = 0, cus = 0, per_cu = 0;
        (void)hipGetDevice(&dev); (void)hipDeviceGetAttribute(&cus, hipDeviceAttributeMultiprocessorCount, dev);
        if (hipOccupancyMaxActiveBlocksPerMultiprocessor(&per_cu, (const void*)mk_fwd, NWAVES * 64, MK_LDS_BYTES) != hipSuccess || per_cu < 1) { fprintf(stderr, "kernel_launch: occupancy query says %d blocks per CU\n", per_cu); (void)hipGetLastError(); }
        grid = cus > 0 ? cus : 256;
    }
    if (grid < 0) return;
    const float* x = (const float*)d_in[0];
    const float* gnw = (const float*)d_in[4];
    unsigned char* ws = (unsigned char*)d_ws; float* out = (float*)d_out;
    float2* rt_ret = (float2*)(ws + WS_RTRET); float2* rt_mla = (float2*)(ws + WS_RTMLA);
    bf16_t *RQ = (bf16_t*)(ws + WS_RQ), *RK = (bf16_t*)(ws + WS_RK), *RV = (bf16_t*)(ws + WS_RV), *RG = (bf16_t*)(ws + WS_RG);
    bf16_t *CQ = (bf16_t*)(ws + WS_CQ), *CKV = (bf16_t*)(ws + WS_CKV), *KPE = (bf16_t*)(ws + WS_KPE), *QB = (bf16_t*)(ws + WS_QB), *KVB = (bf16_t*)(ws + WS_KVB);
    bf16_t *MIX = (bf16_t*)(ws + WS_MIX), *X1B = (bf16_t*)(ws + WS_X1B), *ACT = (bf16_t*)(ws + WS_ACT);
    float *SSQ = (float*)(ws + WS_SSQ), *SSKV = (float*)(ws + WS_SSKV), *SS2 = (float*)(ws + WS_SS2), *SS3 = (float*)(ws + WS_SS3), *NS = (float*)(ws + WS_NS);

    (void)hipMemsetAsync(ws + WS_CTL, 0, CTL_ZERO_BYTES, stream);
    Args a{};
    for (int i = 0; i < 16; ++i) a.in[i] = d_in[i];
    a.out = out; a.ws = ws;
    int li = 0;
    for (int k = 0; k < 8;) {
        if ((OPT_MASK >> k) & 1) {
            if (RET_NAIVE && k == 3) {
                nk3_states<<<2048, 256, 0, stream>>>(RK, RV, NS);
                nk3_scan<<<131072 / 256, 256, 0, stream>>>(NS);
                nk3_out<<<2048, 256, NK3O_LDS, stream>>>(RQ, RK, RV, RG, NS, gnw, MIX);
            }
            int e = k + 1; while (e < 8 && ((OPT_MASK >> e) & 1) && !(RET_NAIVE && e == 3)) ++e;
            a.ph_lo = k; a.ph_hi = e; a.li = li++;
            hipLaunchKernelGGL(mk_fwd, dim3(grid), dim3(NWAVES * 64), MK_LDS_BYTES, stream, a);
            k = e; continue;
        }
        switch (k) {
        case 1: nk1_inproj<<<NT / 4, 256, 0, stream>>>(x, (const float*)d_in[2], (const float*)d_in[3], rt_ret, rt_mla, RQ, RK, RV, RG, CQ, CKV, KPE, SSQ, SSKV); break;
        case 2: nk2_mlaup<<<NT / 4, 256, 0, stream>>>(CQ, CKV, SSQ, SSKV, (const float*)d_in[5], (const float*)d_in[6], (const float*)d_in[7], (const float*)d_in[8], rt_mla, QB, KVB); break;
        case 3:
            nk3_states<<<2048, 256, 0, stream>>>(RK, RV, NS);
            nk3_scan<<<131072 / 256, 256, 0, stream>>>(NS);
            nk3_out<<<2048, 256, NK3O_LDS, stream>>>(RQ, RK, RV, RG, NS, gnw, MIX);
            nk3_attn<<<32 * 1024, 512, 0, stream>>>(QB, KVB, KPE, MIX);
            break;
        case 4: nk4_outproj<<<NT / 4, 256, 0, stream>>>(x, MIX, (const float*)d_in[9], out, X1B, SS2); break;
        case 5: nk5_up<<<NT / 8, 256, 0, stream>>>(out, SS2, (const float*)d_in[10], (const float*)d_in[11], (const float*)d_in[12], (const float*)d_in[13], ACT); break;
        case 6: nk6_down<<<NT / 4, 256, 0, stream>>>(ACT, (const float*)d_in[14], out, SS3); break;
        case 7: nk7_final<<<NT / 4, 256, 0, stream>>>(out, SS3, (const float*)d_in[15]); break;
        default: break;
        }
        ++k;
    }
}
```
